# Optimizing an MI355X kernel written in HIP

```python
import math
import jax, jax.numpy as jnp
from jax import lax
import numpy as np


D_MODEL = 2048
BATCH = 2
SEQ = 4096
DEPTH = 4

HEAD_DIM = 64
RWKV_HEADS = 16
RWKV_DIM = RWKV_HEADS * HEAD_DIM
DECAY_LORA = 96
AAA_LORA = 96
GATE_LORA = 256
ATTN_GROUPS = ((128, 1), (512, 4), (2048, 16))
N_GROUPS = len(ATTN_GROUPS)
ATTN_SLOTS = 8
ATTN_HEADS = N_GROUPS * ATTN_SLOTS
ATTN_DIM = ATTN_HEADS * HEAD_DIM
ATTN_OUT_DIM = ATTN_SLOTS * HEAD_DIM
N_BUCKETS = 32
MAX_DISTANCE = 1024
D_FF = 4 * D_MODEL
N_BRANCHES = 2
RWKV_COLS = 3 * RWKV_DIM + GATE_LORA + 2 * DECAY_LORA + 2 * AAA_LORA
N_IN_COLS = RWKV_COLS + 3 * ATTN_DIM + N_BRANCHES * D_MODEL
RMS_EPS = 1e-6
GN_EPS = 64e-5
L2_EPS = 1e-12

kernel_name = 'hybrid_rwkv7_dilated_attn_encoder'


def rmsnorm(x, g):
    xf = x.astype(jnp.float32)
    y = xf * lax.rsqrt(jnp.mean(xf * xf, axis=-1, keepdims=True) + RMS_EPS)
    return (y * g.astype(jnp.float32)).astype(x.dtype)


def t5_bucket(rel):
    nb = N_BUCKETS // 2
    max_exact = nb // 2
    ret = jnp.where(rel > 0, nb, 0)
    n = jnp.abs(rel)
    nf = jnp.maximum(n, 1).astype(jnp.float32)
    large = max_exact + (jnp.log(nf / max_exact) / math.log(MAX_DISTANCE / max_exact)
                         * (nb - max_exact)).astype(jnp.int32)
    large = jnp.minimum(large, nb - 1)
    return ret + jnp.where(n < max_exact, n, large)


def dilated_window_attention(q, k, v, bias_table, dilation, half):
    B, S, H, Dh = q.shape
    L = S // dilation
    Q = half
    nb = -(-L // Q)
    Lp = nb * Q

    def to_sub(t):
        t = t.reshape(B, L, dilation, H, Dh).transpose(0, 2, 1, 3, 4)
        return jnp.pad(t, ((0, 0), (0, 0), (0, Lp - L), (0, 0), (0, 0)))

    def windows(t):
        t = jnp.pad(to_sub(t), ((0, 0), (0, 0), (Q, Q), (0, 0), (0, 0)))
        t = t.reshape(B, dilation, nb + 2, Q, H, Dh)
        return jnp.concatenate([t[:, :, :-2], t[:, :, 1:-1], t[:, :, 2:]], axis=3)

    qs = to_sub(q).reshape(B, dilation, nb, Q, H, Dh)
    kw = windows(k)
    vw = windows(v)
    rel = jnp.arange(3 * Q)[None, :] - Q - jnp.arange(Q)[:, None]
    band = jnp.abs(rel) <= half
    key_idx = jnp.arange(nb)[:, None] * Q - Q + jnp.arange(3 * Q)[None, :]
    valid = (key_idx >= 0) & (key_idx < L)
    mask = band[None] & valid[:, None, :]
    bias = bias_table[t5_bucket(rel * dilation)].transpose(2, 0, 1)
    logits = jnp.einsum('brnqhd,brnkhd->brnhqk', qs, kw) * (Dh ** -0.5) + bias
    logits = jnp.where(mask[None, None, :, None], logits, -jnp.inf)
    m = jnp.max(logits, axis=-1, keepdims=True)
    p = jnp.exp(logits - m)
    denom = jnp.sum(p, axis=-1, keepdims=True)
    o = jnp.einsum('brnhqk,brnkhd->brnqhd', p / denom, vw)
    lse = (m + jnp.log(denom))[..., 0].transpose(0, 1, 2, 4, 3)

    def from_sub(t):
        t = t.reshape((B, dilation, Lp) + t.shape[4:])[:, :, :L]
        t = jnp.moveaxis(t, 1, 2)
        return t.reshape((B, S) + t.shape[3:])

    return from_sub(o), from_sub(lse)


def attention_branch(q, k, v, rel_bias):
    B, S, _ = q.shape
    heads = lambda t: t.astype(jnp.float32).reshape(B, S, ATTN_HEADS, HEAD_DIM)
    q, k, v = heads(q), heads(k), heads(v)
    table = rel_bias.astype(jnp.float32)
    outs, lses = [], []
    for gi, (window, dilation) in enumerate(ATTN_GROUPS):
        hs = slice(gi * ATTN_SLOTS, (gi + 1) * ATTN_SLOTS)
        o, lse = dilated_window_attention(q[:, :, hs], k[:, :, hs], v[:, :, hs],
                                          table[:, hs], dilation, window // (2 * dilation))
        outs.append(o)
        lses.append(lse)
    wts = jax.nn.softmax(jnp.stack(lses, axis=0), axis=0)
    o = jnp.sum(wts[..., None] * jnp.stack(outs, axis=0), axis=0)
    return o.reshape(B, S, ATTN_OUT_DIM)


def rwkv7_scan(r, w, k, v, kk, a, reverse):
    B, S, H, N = r.shape

    def step(state, inp):
        r_t, w_t, k_t, v_t, kk_t, a_t = inp
        sk = jnp.einsum('bhij,bhj->bhi', state, kk_t)
        state = (state * w_t[:, :, None, :] - sk[..., :, None] * (kk_t * a_t)[:, :, None, :]
                 + v_t[..., :, None] * k_t[:, :, None, :])
        return state, jnp.einsum('bhij,bhj->bhi', state, r_t)

    xs = tuple(jnp.moveaxis(t, 1, 0) for t in (r, w, k, v, kk, a))
    s0 = jnp.zeros((B, H, N, N), jnp.float32)
    _, y = lax.scan(step, s0, xs, reverse=reverse)
    return jnp.moveaxis(y, 0, 1)


def rwkv_branch(slab, mu, w0, w_up, a0, a_up, g_up, k_k, k_a, r_k, gn_w, gn_b):
    f32 = lambda t: t.astype(jnp.float32)
    slab = f32(slab)
    B, S, _ = slab.shape
    prev = jnp.pad(slab[:, :-1], ((0, 0), (1, 0), (0, 0)))
    nxt = jnp.pad(slab[:, 1:], ((0, 0), (0, 1), (0, 0)))
    p = slab + f32(mu) * (0.5 * (prev + nxt) - slab)
    splits = np.cumsum([RWKV_DIM, RWKV_DIM, RWKV_DIM, GATE_LORA, DECAY_LORA, DECAY_LORA, AAA_LORA])
    r, k, v, gd, wdf, wdb, adf, adb = jnp.split(p, splits, axis=-1)
    heads = lambda t: t.reshape(B, S, RWKV_HEADS, HEAD_DIM)
    g = jnp.matmul(jax.nn.sigmoid(gd), f32(g_up))
    kk = heads(k * f32(k_k))
    kk = kk / jnp.maximum(jnp.sqrt(jnp.sum(kk * kk, axis=-1, keepdims=True)), L2_EPS)
    rh, vh = heads(r), heads(v)
    y = jnp.zeros_like(rh)
    bonus = jnp.zeros_like(rh)
    for direction, (wd, ad) in enumerate(((wdf, adf), (wdb, adb))):
        wl = -jax.nn.softplus(-(f32(w0[direction]) + jnp.matmul(jnp.tanh(wd), f32(w_up[direction])))) - 0.5
        decay = jnp.exp(-jnp.exp(wl))
        a = jax.nn.sigmoid(f32(a0[direction]) + jnp.matmul(ad, f32(a_up[direction])))
        kd = heads(k * (1.0 + (a - 1.0) * f32(k_a)))
        y = y + rwkv7_scan(rh, heads(decay), kd, vh, kk, heads(a), reverse=(direction == 1))
        bonus = bonus + jnp.sum(rh * kd * f32(r_k), axis=-1, keepdims=True) * vh
    mean = jnp.mean(y, axis=-1, keepdims=True)
    var = jnp.mean(jnp.square(y - mean), axis=-1, keepdims=True)
    yn = ((y - mean) * lax.rsqrt(var + GN_EPS)).reshape(B, S, RWKV_DIM) * f32(gn_w) + f32(gn_b)
    return (yn + bonus.reshape(B, S, RWKV_DIM)) * g


def setup_inputs(seed: int = 0) -> dict:
    key = jax.random.key(seed)
    ks = jax.random.split(key, 24)
    nrm = lambda kk_, shape, scale: scale * jax.random.normal(kk_, shape, jnp.float32)
    x = nrm(ks[0], (BATCH, SEQ, D_MODEL), 1.0)
    norm1_g = 1.0 + nrm(ks[1], (DEPTH, D_MODEL), 0.02)
    w_in = nrm(ks[2], (DEPTH, D_MODEL, N_IN_COLS), D_MODEL ** -0.5)
    tshift_mu = jax.random.uniform(ks[3], (DEPTH, RWKV_COLS), jnp.float32, 0.2, 0.8)
    w0 = jax.random.uniform(ks[4], (DEPTH, 2, RWKV_DIM), jnp.float32, -6.5, -0.5)
    w_lora_up = nrm(ks[5], (DEPTH, 2, DECAY_LORA, RWKV_DIM), 0.5 * DECAY_LORA ** -0.5)
    a0 = nrm(ks[6], (DEPTH, 2, RWKV_DIM), 0.5)
    a_lora_up = nrm(ks[7], (DEPTH, 2, AAA_LORA, RWKV_DIM), 0.5 * AAA_LORA ** -0.5)
    g_lora_up = nrm(ks[8], (DEPTH, GATE_LORA, RWKV_DIM), GATE_LORA ** -0.5)
    k_k = 0.85 + nrm(ks[9], (DEPTH, RWKV_DIM), 0.05)
    k_a = 1.0 + nrm(ks[10], (DEPTH, RWKV_DIM), 0.05)
    r_k = nrm(ks[11], (DEPTH, RWKV_HEADS, HEAD_DIM), 0.1)
    gn_w = 1.0 + nrm(ks[12], (DEPTH, RWKV_DIM), 0.02)
    gn_b = nrm(ks[13], (DEPTH, RWKV_DIM), 0.02)
    rel_bias = nrm(ks[14], (N_BUCKETS, ATTN_HEADS), 0.5)
    w_branch_rwkv = nrm(ks[15], (DEPTH, RWKV_DIM, D_MODEL), RWKV_DIM ** -0.5)
    w_branch_attn = nrm(ks[16], (DEPTH, ATTN_OUT_DIM, D_MODEL), ATTN_OUT_DIM ** -0.5)
    w_out = nrm(ks[17], (DEPTH, D_MODEL, D_MODEL), D_MODEL ** -0.5)
    norm2_g = 1.0 + nrm(ks[18], (DEPTH, D_MODEL), 0.02)
    w_mlp_in = nrm(ks[19], (DEPTH, D_MODEL, D_FF), D_MODEL ** -0.5)
    w_mlp_out = nrm(ks[20], (DEPTH, D_FF, D_MODEL), D_FF ** -0.5)
    final_g = 1.0 + nrm(ks[21], (D_MODEL,), 0.02)
    return {'x': x, 'norm1_g': norm1_g, 'w_in': w_in, 'tshift_mu': tshift_mu, 'w0': w0,
            'w_lora_up': w_lora_up, 'a0': a0, 'a_lora_up': a_lora_up, 'g_lora_up': g_lora_up,
            'k_k': k_k, 'k_a': k_a, 'r_k': r_k, 'gn_w': gn_w, 'gn_b': gn_b, 'rel_bias': rel_bias,
            'w_branch_rwkv': w_branch_rwkv, 'w_branch_attn': w_branch_attn, 'w_out': w_out,
            'norm2_g': norm2_g, 'w_mlp_in': w_mlp_in, 'w_mlp_out': w_mlp_out, 'final_g': final_g}


def reference(x, norm1_g, w_in, tshift_mu, w0, w_lora_up, a0, a_lora_up, g_lora_up, k_k, k_a,
              r_k, gn_w, gn_b, rel_bias, w_branch_rwkv, w_branch_attn, w_out, norm2_g,
              w_mlp_in, w_mlp_out, final_g):
    dtype = x.dtype
    cuts = [RWKV_COLS, RWKV_COLS + ATTN_DIM, RWKV_COLS + 2 * ATTN_DIM, RWKV_COLS + 3 * ATTN_DIM]
    h = x
    for l in range(DEPTH):
        u = rmsnorm(h, norm1_g[l])
        proj = jnp.matmul(u, w_in[l])
        slab, q, k, v, gates = jnp.split(proj, cuts, axis=-1)
        o_rwkv = rwkv_branch(slab, tshift_mu[l], w0[l], w_lora_up[l], a0[l], a_lora_up[l],
                             g_lora_up[l], k_k[l], k_a[l], r_k[l], gn_w[l], gn_b[l]).astype(dtype)
        o_attn = attention_branch(q, k, v, rel_bias).astype(dtype)
        gate = jax.nn.sigmoid(gates.astype(jnp.float32)).astype(dtype)
        g_rwkv, g_attn = jnp.split(gate, 2, axis=-1)
        merged = (g_rwkv * jnp.matmul(o_rwkv, w_branch_rwkv[l])
                  + g_attn * jnp.matmul(o_attn, w_branch_attn[l]))
        h = h + jnp.matmul(merged, w_out[l])
        u = rmsnorm(h, norm2_g[l])
        h = h + jnp.matmul(jnp.square(jax.nn.relu(jnp.matmul(u, w_mlp_in[l]))), w_mlp_out[l])
    return rmsnorm(h, final_g)
```

```cpp
#include <hip/hip_runtime.h>
#include <cstdio>
#include <cstdint>

#define GAS __attribute__((address_space(1)))
#define LAS __attribute__((address_space(3)))
typedef unsigned short bf16_t;
typedef short bf16x8 __attribute__((ext_vector_type(8)));
typedef float f32x2 __attribute__((ext_vector_type(2)));
typedef float f32x4 __attribute__((ext_vector_type(4)));
typedef float f32x16 __attribute__((ext_vector_type(16)));
typedef unsigned u32x2 __attribute__((ext_vector_type(2)));
typedef unsigned u32x4 __attribute__((ext_vector_type(4)));

constexpr int DM = 2048, BATCH = 2, SEQ = 4096, DEPTH = 4, M = BATCH * SEQ;
constexpr int HD = 64, RH = 16, RD = 1024;
constexpr int RWKV_COLS = 3712, SLABP = 3840;
constexpr int AH = 24, AD = 1536, AOD = 512;
constexpr int NIN = 12416, NINP = 12544;
constexpr int QOFF = SLABP, KOFF = SLABP + AD, VOFF = SLABP + 2 * AD, GOFF = SLABP + 3 * AD;
constexpr int DFF = 8192;
constexpr int LORA_K = 768, LORA_N = 5120;
constexpr int OCAT = 1536;
constexpr float RMS_EPS = 1e-6f, GN_EPS = 64e-5f;
constexpr int NWAVES = 8, NTHREADS = 512;

constexpr size_t MiB = 1u << 20;
constexpr size_t WS_CTL = 0, CTL_ZERO_BYTES = 1 * MiB;
constexpr size_t WS_BTAB = 1 * MiB;
constexpr size_t WS_SSQA = WS_BTAB + 64 * 1024, WS_SSQB = WS_SSQA + 64 * 1024;
constexpr size_t WS_W = 2 * MiB;
constexpr size_t W_IN_B = (size_t)NINP * DM * 2, W_BR_B = (size_t)DM * OCAT * 2, W_OUT_B = (size_t)DM * DM * 2, W_MI_B = (size_t)DFF * DM * 2, W_MO_B = (size_t)DM * DFF * 2, W_LORA_B = (size_t)LORA_N * LORA_K * 2;
constexpr size_t WO_IN = 0, WO_BR = WO_IN + W_IN_B, WO_OUT = WO_BR + W_BR_B, WO_MI = WO_OUT + W_OUT_B, WO_MO = WO_MI + W_MI_B, WO_LORA = WO_MO + W_MO_B, W_LAYER_B = WO_LORA + W_LORA_B;
constexpr size_t WS_ACT = WS_W + DEPTH * W_LAYER_B;
constexpr size_t A_HB = 0;
constexpr size_t A_H = A_HB + (size_t)M * DM * 2;
constexpr size_t A_BS = A_H;
constexpr size_t A_PROJ = A_H + (size_t)M * DM * 4;
constexpr size_t A_R = A_PROJ + (size_t)M * NINP * 2;
constexpr size_t F32RD = (size_t)M * RD * 4;
constexpr size_t A_K = A_R + F32RD, A_V = A_K + F32RD, A_KK = A_V + F32RD, A_WF = A_KK + F32RD, A_WB = A_WF + F32RD, A_AF = A_WB + F32RD, A_AB = A_AF + F32RD, A_G = A_AB + F32RD;
constexpr size_t A_Y = A_G + F32RD;
constexpr size_t A_OG = A_Y + 2 * F32RD;
constexpr size_t A_LSE = A_OG + (size_t)3 * M * AOD * 4;
constexpr size_t A_VT = A_LSE + (size_t)3 * M * 8 * 4;
constexpr size_t A_LIN = A_VT + (size_t)BATCH * AH * HD * SEQ * 2;
constexpr size_t A_OCAT = A_LIN + (size_t)M * LORA_K * 2;
constexpr int SCT = 32, NCHUNK = SEQ / SCT;
constexpr int FR_STRIDE = 29 * 1024;
constexpr int FR_AT = 0, FR_RT = 4, FR_LK = 8, FR_TI = 10, FR_MB = 12, FR_MK = 14, FR_BP = 16, FR_KP = 20, FR_VF = 24, FR_CT_BYTE = 28 * 1024;
constexpr size_t A_FR = A_LIN;
constexpr size_t FR_BYTES = (size_t)BATCH * RH * 2 * NCHUNK * FR_STRIDE;
constexpr size_t A_END = (A_OCAT + (size_t)M * OCAT * 2) > (A_FR + FR_BYTES) ? (A_OCAT + (size_t)M * OCAT * 2) : (A_FR + FR_BYTES);
constexpr size_t WS_END = WS_ACT + A_END;
static_assert((size_t)M * DFF * 2 <= (size_t)M * NINP * 2, "HID overlays PROJ");

constexpr int RING_BYTES = 139264;
constexpr int MISC_OFF = RING_BYTES;
constexpr int SCAN_NSLOT = 4;
constexpr int SCAN_LSLOT = 28 * 1024 + 256;
constexpr int SCAN_NSW = 0;
#define SCAN_WG_WORKER(w) (SCAN_NSW == 6 ? (w) - 2 : (SCAN_NSW == 4 ? ((w) == 2 || (w) == 3 ? (w) - 2 : ((w) >= 6 ? (w) - 4 : -1)) : -1))
constexpr int PARAM_OFF = RING_BYTES + 256;
constexpr int LDS_BYTES = PARAM_OFF + NWAVES * 512;

typedef __bf16 bf16x2_t __attribute__((ext_vector_type(2)));
__device__ __forceinline__ unsigned cvt_pk_bf16(float lo, float hi) { f32x2 v = {lo, hi}; bf16x2_t b = __builtin_convertvector(v, bf16x2_t); return __builtin_bit_cast(unsigned, b); }
__device__ __forceinline__ float bf_lo(unsigned u) { return __uint_as_float(u << 16); }
__device__ __forceinline__ float bf_hi(unsigned u) { return __uint_as_float(u & 0xffff0000u); }
__device__ __forceinline__ float bf1(bf16_t u) { return __uint_as_float(((unsigned)u) << 16); }
__device__ __forceinline__ float sigmoidf_(float x) { return __builtin_amdgcn_rcpf(1.0f + __expf(-x)); }
__device__ __forceinline__ void unpack8(const u32x4 w, float (&f)[8]) { f[0] = bf_lo(w.x); f[1] = bf_hi(w.x); f[2] = bf_lo(w.y); f[3] = bf_hi(w.y); f[4] = bf_lo(w.z); f[5] = bf_hi(w.z); f[6] = bf_lo(w.w); f[7] = bf_hi(w.w); }
__device__ __forceinline__ u32x4 pack8(const float (&f)[8]) { u32x4 w; w.x = cvt_pk_bf16(f[0], f[1]); w.y = cvt_pk_bf16(f[2], f[3]); w.z = cvt_pk_bf16(f[4], f[5]); w.w = cvt_pk_bf16(f[6], f[7]); return w; }

__device__ __forceinline__ f32x4 ld4bf(const bf16_t* p) { const u32x2 w = *(const u32x2*)p; return (f32x4){bf_lo(w.x), bf_hi(w.x), bf_lo(w.y), bf_hi(w.y)}; }
typedef unsigned long long u64;
__device__ __forceinline__ void ssq_add(u64* p, float s) { atomicAdd(p, (u64)(s * 16777216.0f + 0.5f)); }
__device__ __forceinline__ float ssq_get(const u64* p) { return (float)(*p) * (1.0f / 16777216.0f); }
namespace pg8 {
constexpr int BM = 256, BK = 64, HALF = 128, HTB = HALF * BK * 2, STAGE_BYTES = 8 * HTB, NXCD = 8, WGM = 8;
__host__ __device__ __forceinline__ int lds_byte(int r, int c) { const int st = (r >> 4) * 2 + (c >> 5), rr = r & 15, cc = c & 31, ob = rr * 64 + cc * 2; return st * 1024 + (ob ^ (((ob >> 9) & 1) << 5)); }
__host__ __device__ __forceinline__ void stage_rc(int b, int& R, int& C) { const int st = b / 1024, sb = b % 1024, swz = sb ^ (((sb >> 9) & 1) << 5); R = (st >> 1) * 16 + swz / 64; C = (st & 1) * 32 + (swz % 64) / 2; }
__host__ __device__ __forceinline__ int perm32(int rho) { const int n = rho >> 4, i = rho & 15; return 8 * (i >> 2) + 4 * n + (i & 3); }

struct Unit { int pm, pn, koff, nt, tag; };
struct Gemm { const bf16_t* A; const bf16_t* Bt; int lda, ldb; };

struct StaticOrder {
    int nM, nN, nwg, G, c;
    __device__ void init(int M_, int N_, int G_, int c_) { nM = M_ / BM; nN = N_ / BM; nwg = nM * nN; G = G_; c = c_; }
    __device__ bool map(int i, int& pm, int& pn) const {
        const long L = (long)i * G + c; if (L >= nwg) return false;
        int wgid = (int)L; { const int q = nwg / NXCD, r = nwg % NXCD, xcd = wgid % NXCD, off = wgid / NXCD; wgid = (xcd < r ? xcd * (q + 1) : r * (q + 1) + (xcd - r) * q) + off; }
        const int nig = WGM * nN, gid = wgid / nig, fm = gid * WGM, gsz = (nM - fm) < WGM ? (nM - fm) : WGM;
        pm = fm + ((wgid % nig) % gsz); pn = (wgid % nig) / gsz; return true;
    }
};
struct PlainSched : StaticOrder {
    int nt;
    __device__ bool next(int i, Unit& u) const { if (!map(i, u.pm, u.pn)) return false; u.koff = 0; u.nt = nt; u.tag = 0; return true; }
};

template <class Epi, class Sched, bool ALIGN_EPI>
__device__ __forceinline__ void gemm_phase(LAS unsigned char* lds, const int tid, const Gemm g, const Sched& S, const Epi& E) {
    const int wid = __builtin_amdgcn_readfirstlane(tid >> 6), lane = tid & 63, wr = wid >> 2, wc = wid & 3, fr = lane & 15, fq = lane >> 4;
    const int lda = g.lda, ldb = g.ldb;
    unsigned voffA[2], voffB[2];
#pragma unroll
    for (int i = 0; i < 2; ++i) { int R, C; stage_rc(tid * 16 + i * 8192, R, C); const int Rb = Epi::PERM ? ((R & ~31) + perm32(R & 31)) : R;
        voffA[i] = (unsigned)(R * lda + C) * 2u; voffB[i] = (unsigned)(Rb * ldb + C) * 2u; }
    const size_t kstep = (size_t)(BK * 2);
    const size_t hstepA = (size_t)HALF * lda * 2, hstepB = (size_t)HALF * ldb * 2;
    const unsigned ldsw = (unsigned)wid * 1024u;
    const int aoff = lds_byte(wr * 64 + fr, fq * 8), boff = lds_byte(wc * 32 + fr, fq * 8);
#define PG8_SA(b, h) (((b) * 2 + (h)) * HTB)
#define PG8_SB(b, h) ((4 + (b) * 2 + (h)) * HTB)
#define PG8_STAGE(bufoff, gbase, voff) do { _Pragma("unroll") for (int _i = 0; _i < 2; ++_i) \
        __builtin_amdgcn_global_load_lds((const unsigned*)((const char*)(gbase) + (voff)[_i]), (LAS unsigned*)(lds + (bufoff) + ldsw + _i * 8192), 16, 0, 0); } while (0)
#define PG8_LDA(dst, b, h) do { _Pragma("unroll") for (int m = 0; m < 4; ++m) _Pragma("unroll") for (int k = 0; k < 2; ++k) dst[m][k] = *(const LAS bf16x8*)(lds + PG8_SA(b, h) + aoff + m * 2048 + k * 1024); } while (0)
#define PG8_LDB(dst, b, h) do { _Pragma("unroll") for (int n = 0; n < 2; ++n) _Pragma("unroll") for (int k = 0; k < 2; ++k) dst[n][k] = *(const LAS bf16x8*)(lds + PG8_SB(b, h) + boff + n * 2048 + k * 1024); } while (0)
#define PG8_MMA(ai, bj, At, Bt) do { __builtin_amdgcn_s_setprio(1); _Pragma("unroll") for (int m = 0; m < 4; ++m) _Pragma("unroll") for (int n = 0; n < 2; ++n) _Pragma("unroll") for (int k = 0; k < 2; ++k) \
        acc[ai][bj][m][n] = __builtin_amdgcn_mfma_f32_16x16x32_bf16(Bt[n][k], At[m][k], acc[ai][bj][m][n], 0, 0, 0); __builtin_amdgcn_s_setprio(0); } while (0)
#define PG8_WAIT_V(n) asm volatile("s_waitcnt vmcnt(" #n ")" ::: "memory")
#define PG8_WAIT_L(n) asm volatile("s_waitcnt lgkmcnt(" #n ")" ::: "memory")
#define PG8_BAR __builtin_amdgcn_s_barrier()
#define PG8_SCHED __builtin_amdgcn_sched_barrier(0)
    Unit cur, nxt; int ui = 0;
    if (!S.next(0, cur)) return;
    f32x4 acc[2][2][4][2];
#pragma unroll
    for (int a = 0; a < 2; ++a)
#pragma unroll
        for (int b = 0; b < 2; ++b)
#pragma unroll
            for (int m = 0; m < 4; ++m)
#pragma unroll
                for (int n = 0; n < 2; ++n) acc[a][b][m][n] = (f32x4){0.f, 0.f, 0.f, 0.f};
    bf16x8 At[4][2], B0[2][2], B1[2][2];
    const char* cA = (const char*)g.A + ((size_t)cur.pm * BM * lda + cur.koff) * 2; const char* cB = (const char*)g.Bt + ((size_t)cur.pn * BM * ldb + cur.koff) * 2;
#define PG8_RSDMA(pm_, par_) do { if constexpr (Epi::RS) if (wid == 0) { const char* sp_ = (const char*)E.ssq + ((size_t)(pm_) * BM + lane * 2) * 8; \
        __builtin_amdgcn_global_load_lds((const unsigned*)sp_, (LAS unsigned*)(lds + STAGE_BYTES + (par_) * 2048), 16, 0, 0); \
        __builtin_amdgcn_global_load_lds((const unsigned*)(sp_ + 1024), (LAS unsigned*)(lds + STAGE_BYTES + (par_) * 2048 + 1024), 16, 0, 0); } } while (0)
    PG8_RSDMA(cur.pm, 0);
    PG8_STAGE(PG8_SB(0, 0), cB, voffB); PG8_STAGE(PG8_SB(0, 1), cB + hstepB, voffB); PG8_STAGE(PG8_SA(0, 0), cA, voffA); PG8_STAGE(PG8_SA(0, 1), cA + hstepA, voffA);
    if (wr == 1) PG8_BAR;
    PG8_WAIT_V(2); PG8_BAR;
    PG8_STAGE(PG8_SB(1, 0), cB + kstep, voffB); PG8_STAGE(PG8_SA(1, 0), cA + kstep, voffA); PG8_STAGE(PG8_SB(1, 1), cB + hstepB + kstep, voffB);
    PG8_WAIT_V(6); PG8_BAR;
    for (;;) {
        const bool has_next = S.next(ui + 1, nxt);
        const char* nA = has_next ? (const char*)g.A + ((size_t)nxt.pm * BM * lda + nxt.koff) * 2 : cA; const char* nB = has_next ? (const char*)g.Bt + ((size_t)nxt.pn * BM * ldb + nxt.koff) * 2 : cB;
        const int nt = cur.nt;
        for (int t = 0; t < nt; t += 2) {
            const bool last = (t == nt - 2);
            if (last && has_next) PG8_RSDMA(nxt.pm, (ui + 1) & 1);
            const char* a1 = cA + (size_t)(t + 1) * kstep;
            const char* a2 = last ? nA : cA + (size_t)(t + 2) * kstep; const char* b2 = last ? nB : cB + (size_t)(t + 2) * kstep;
            const char* a3 = a2 + kstep; const char* b3 = b2 + kstep;
            PG8_LDB(B0, 0, 0); PG8_LDB(B1, 0, 1); PG8_SCHED; PG8_LDA(At, 0, 0); PG8_STAGE(PG8_SA(1, 1), a1 + hstepA, voffA);
            PG8_WAIT_V(8); PG8_WAIT_L(0); PG8_BAR; PG8_MMA(0, 0, At, B0); PG8_MMA(0, 1, At, B1); PG8_BAR; PG8_SCHED;
            PG8_LDA(At, 0, 1); PG8_STAGE(PG8_SB(0, 0), b2, voffB); PG8_STAGE(PG8_SB(0, 1), b2 + hstepB, voffB); PG8_STAGE(PG8_SA(0, 0), a2, voffA);
            PG8_WAIT_V(8); PG8_WAIT_L(0); PG8_BAR; PG8_MMA(1, 0, At, B0); PG8_MMA(1, 1, At, B1); PG8_BAR; PG8_SCHED;
            PG8_LDB(B0, 1, 0); PG8_LDB(B1, 1, 1); PG8_SCHED; PG8_LDA(At, 1, 0); PG8_STAGE(PG8_SA(0, 1), a2 + hstepA, voffA);
            PG8_WAIT_V(8); PG8_WAIT_L(0); PG8_BAR; PG8_MMA(0, 0, At, B0); PG8_MMA(0, 1, At, B1); PG8_BAR; PG8_SCHED;
            PG8_LDA(At, 1, 1); PG8_STAGE(PG8_SB(1, 0), b3, voffB); PG8_STAGE(PG8_SB(1, 1), b3 + hstepB, voffB); PG8_STAGE(PG8_SA(1, 0), a3, voffA);
            PG8_WAIT_V(8); PG8_WAIT_L(0); PG8_BAR; PG8_MMA(1, 0, At, B0); PG8_MMA(1, 1, At, B1); PG8_BAR; PG8_SCHED;
        }
        if constexpr (ALIGN_EPI) { if (wr == 0) PG8_BAR; }
        const bool keep = E(acc, cur, wr, wc, fr, fq, (const LAS u64*)(lds + STAGE_BYTES + (ui & 1) * 2048));
        if (!has_next) break;
        if (!keep) {
#pragma unroll
        for (int a = 0; a < 2; ++a)
#pragma unroll
            for (int b = 0; b < 2; ++b)
#pragma unroll
                for (int m = 0; m < 4; ++m)
#pragma unroll
                    for (int n = 0; n < 2; ++n) acc[a][b][m][n] = (f32x4){0.f, 0.f, 0.f, 0.f};
        }
        cur = nxt; cA = nA; cB = nB; ++ui;
        if constexpr (ALIGN_EPI) { if (wr == 1) PG8_BAR; }
    }
    PG8_WAIT_V(0);
    if constexpr (!ALIGN_EPI) { if (wr == 0) PG8_BAR; }
    PG8_BAR;
#undef PG8_RSDMA
#undef PG8_SA
#undef PG8_SB
#undef PG8_STAGE
#undef PG8_LDA
#undef PG8_LDB
#undef PG8_MMA
#undef PG8_WAIT_V
#undef PG8_WAIT_L
#undef PG8_BAR
#undef PG8_SCHED
}

typedef f32x4 Acc[2][2][4][2];
struct EpiProj {
    static constexpr bool PERM = true, RS = true;
    bf16_t* O; const u64* ssq;
    __device__ __forceinline__ bool operator()(Acc& acc, const Unit& u, int wr, int wc, int fr, int fq, const LAS u64* rstab) const {
        const int row0 = u.pm * BM + wr * 64 + fr, col0 = u.pn * BM + wc * 32 + 8 * fq;
        const int kind = (u.pn >= GOFF / 256) ? 2 : ((u.pn >= QOFF / 256 && u.pn < KOFF / 256) ? 1 : 0);
#pragma unroll
        for (int ai = 0; ai < 2; ++ai)
#pragma unroll
            for (int m = 0; m < 4; ++m) { const int row = row0 + ai * HALF + m * 16;
                float rs = __builtin_amdgcn_rsqf((float)rstab[row - u.pm * BM] * (1.0f / 16777216.0f / DM) + RMS_EPS); if (kind == 1) rs *= 0.125f;
                bf16_t* rowp = O + (size_t)row * NINP + col0;
#pragma unroll
                for (int bj = 0; bj < 2; ++bj) { f32x4 v0 = acc[ai][bj][m][0] * rs, v1 = acc[ai][bj][m][1] * rs;
                    if (kind == 2) {
#pragma unroll
                        for (int j = 0; j < 4; ++j) { v0[j] = sigmoidf_(v0[j]); v1[j] = sigmoidf_(v1[j]); } }
                    u32x4 w; w.x = cvt_pk_bf16(v0[0], v0[1]); w.y = cvt_pk_bf16(v0[2], v0[3]); w.z = cvt_pk_bf16(v1[0], v1[1]); w.w = cvt_pk_bf16(v1[2], v1[3]);
                    *(u32x4*)(rowp + bj * HALF) = w; } }
        return false;
    }
};
struct EpiMlpIn {
    static constexpr bool PERM = true, RS = true;
    bf16_t* O; const u64* ssq;
    __device__ __forceinline__ bool operator()(Acc& acc, const Unit& u, int wr, int wc, int fr, int fq, const LAS u64* rstab) const {
        const int row0 = u.pm * BM + wr * 64 + fr, col0 = u.pn * BM + wc * 32 + 8 * fq;
#pragma unroll
        for (int ai = 0; ai < 2; ++ai)
#pragma unroll
            for (int m = 0; m < 4; ++m) { const int row = row0 + ai * HALF + m * 16;
                const float rs = __builtin_amdgcn_rsqf((float)rstab[row - u.pm * BM] * (1.0f / 16777216.0f / DM) + RMS_EPS);
                bf16_t* rowp = O + (size_t)row * DFF + col0;
#pragma unroll
                for (int bj = 0; bj < 2; ++bj) { f32x4 v0 = acc[ai][bj][m][0] * rs, v1 = acc[ai][bj][m][1] * rs;
#pragma unroll
                    for (int j = 0; j < 4; ++j) { const float a = fmaxf(v0[j], 0.f), b = fmaxf(v1[j], 0.f); v0[j] = a * a; v1[j] = b * b; }
                    u32x4 w; w.x = cvt_pk_bf16(v0[0], v0[1]); w.y = cvt_pk_bf16(v0[2], v0[3]); w.z = cvt_pk_bf16(v1[0], v1[1]); w.w = cvt_pk_bf16(v1[2], v1[3]);
                    *(u32x4*)(rowp + bj * HALF) = w; } }
        return false;
    }
};
template <bool BASE_F32> struct EpiResid {
    static constexpr bool PERM = true, RS = false;
    const void* base; bf16_t* HB; u64* ssq;
    __device__ __forceinline__ bool operator()(Acc& acc, const Unit& u, int wr, int wc, int fr, int fq, const LAS u64* rstab) const {
        const int row0 = u.pm * BM + wr * 64 + fr, col0 = u.pn * BM + wc * 32 + 8 * fq;
#pragma unroll
        for (int ai = 0; ai < 2; ++ai) {
            f32x4 bb[4][2][2];
#pragma unroll
            for (int m = 0; m < 4; ++m)
#pragma unroll
                for (int bj = 0; bj < 2; ++bj) { const size_t off = (size_t)(row0 + ai * HALF + m * 16) * DM + col0 + bj * HALF;
                    if (BASE_F32) { bb[m][bj][0] = *(const f32x4*)((const float*)base + off); bb[m][bj][1] = *(const f32x4*)((const float*)base + off + 4); }
                    else { const u32x4 w = *(const u32x4*)((const bf16_t*)base + off); bb[m][bj][0] = (f32x4){bf_lo(w.x), bf_hi(w.x), bf_lo(w.y), bf_hi(w.y)}; bb[m][bj][1] = (f32x4){bf_lo(w.z), bf_hi(w.z), bf_lo(w.w), bf_hi(w.w)}; } }
            __builtin_amdgcn_sched_barrier(0);
#pragma unroll
            for (int m = 0; m < 4; ++m) { const int row = row0 + ai * HALF + m * 16; float s = 0.f;
#pragma unroll
                for (int bj = 0; bj < 2; ++bj) { const size_t off = (size_t)row * DM + col0 + bj * HALF;
                    const f32x4 a0 = acc[ai][bj][m][0], a1 = acc[ai][bj][m][1]; float o[8];
#pragma unroll
                    for (int j = 0; j < 4; ++j) { o[j] = bb[m][bj][0][j] + a0[j]; o[4 + j] = bb[m][bj][1][j] + a1[j]; }
#pragma unroll
                    for (int j = 0; j < 8; ++j) s += o[j] * o[j];
                    *(u32x4*)(HB + off) = pack8(o); }
                s += __shfl_xor(s, 16); s += __shfl_xor(s, 32);
                if (fq == 0) ssq_add(ssq + row, s); } }
        return false;
    }
};
struct EpiBranch {
    static constexpr bool PERM = true, RS = false;
    bf16_t* O; const bf16_t* proj;
    __device__ __forceinline__ bool operator()(Acc& acc, const Unit& u, int wr, int wc, int fr, int fq, const LAS u64* rstab) const {
        const int row0 = u.pm * BM + wr * 64 + fr, col0 = u.pn * BM + wc * 32 + 8 * fq;
        if (u.tag == 0) {
#pragma unroll
            for (int ai = 0; ai < 2; ++ai) { u32x4 gr[4][2], ga[4][2];
#pragma unroll
                for (int m = 0; m < 4; ++m)
#pragma unroll
                    for (int bj = 0; bj < 2; ++bj) { const bf16_t* gp = proj + (size_t)(row0 + ai * HALF + m * 16) * NINP + GOFF + col0 + bj * HALF; gr[m][bj] = *(const u32x4*)gp; ga[m][bj] = *(const u32x4*)(gp + DM); }
                __builtin_amdgcn_sched_barrier(0);
#pragma unroll
                for (int m = 0; m < 4; ++m)
#pragma unroll
                    for (int bj = 0; bj < 2; ++bj) { float r8[8], a8[8]; unpack8(gr[m][bj], r8); unpack8(ga[m][bj], a8);
#pragma unroll
                        for (int j = 0; j < 4; ++j) { acc[ai][bj][m][0][j] *= a8[j] * __builtin_amdgcn_rcpf(r8[j]); acc[ai][bj][m][1][j] *= a8[4 + j] * __builtin_amdgcn_rcpf(r8[4 + j]); } } }
            return true;
        }
#pragma unroll
        for (int ai = 0; ai < 2; ++ai) { u32x4 gr[4][2];
#pragma unroll
            for (int m = 0; m < 4; ++m)
#pragma unroll
                for (int bj = 0; bj < 2; ++bj) gr[m][bj] = *(const u32x4*)(proj + (size_t)(row0 + ai * HALF + m * 16) * NINP + GOFF + col0 + bj * HALF);
            __builtin_amdgcn_sched_barrier(0);
#pragma unroll
            for (int m = 0; m < 4; ++m)
#pragma unroll
                for (int bj = 0; bj < 2; ++bj) { float r8[8]; unpack8(gr[m][bj], r8); const f32x4 v0 = acc[ai][bj][m][0], v1 = acc[ai][bj][m][1];
                    u32x4 w; w.x = cvt_pk_bf16(v0[0] * r8[0], v0[1] * r8[1]); w.y = cvt_pk_bf16(v0[2] * r8[2], v0[3] * r8[3]); w.z = cvt_pk_bf16(v1[0] * r8[4], v1[1] * r8[5]); w.w = cvt_pk_bf16(v1[2] * r8[6], v1[3] * r8[7]);
                    *(u32x4*)(O + (size_t)(row0 + ai * HALF + m * 16) * DM + col0 + bj * HALF) = w; } }
        return false;
    }
};
struct EpiLora {
    static constexpr bool PERM = false, RS = false;
    unsigned char* act; const float *w0, *a0;
    __device__ __forceinline__ bool operator()(Acc& acc, const Unit& u, int wr, int wc, int fr, int fq, const LAS u64* rstab) const {
        const int row0 = u.pm * BM + wr * 64 + fr, cb = u.tag, c0 = (u.pn & 3) * BM + wc * 32 + 4 * fq;
        const size_t eo = (size_t)row0 * RD + c0;
        bf16_t* Ob = (bf16_t*)(act + (cb == 0 ? A_G : (cb <= 2 ? A_WF + (size_t)(cb - 1) * F32RD : A_AF + (size_t)(cb - 3) * F32RD))) + eo;
        const float* pv = (cb >= 3 ? a0 + (cb - 3) * RD : w0 + (cb == 2 ? RD : 0)) + c0;
        if (cb == 0) {
#pragma unroll
            for (int bj = 0; bj < 2; ++bj)
#pragma unroll
                for (int n = 0; n < 2; ++n)
#pragma unroll
                    for (int ai = 0; ai < 2; ++ai)
#pragma unroll
                        for (int m = 0; m < 4; ++m) { const f32x4 a = acc[ai][bj][m][n]; const size_t oo = (size_t)(ai * HALF + m * 16) * RD + bj * HALF + n * 16;
                            u32x2 w; w.x = cvt_pk_bf16(a[0], a[1]); w.y = cvt_pk_bf16(a[2], a[3]); *(u32x2*)(Ob + oo) = w; }
            return false;
        }
        f32x4 p0v[2][2];
#pragma unroll
        for (int bj = 0; bj < 2; ++bj)
#pragma unroll
            for (int n = 0; n < 2; ++n) p0v[bj][n] = *(const f32x4*)(pv + bj * HALF + n * 16);
        __builtin_amdgcn_sched_barrier(0);
        const float osc = (cb <= 2) ? -0.87503878f : 1.0f;
#pragma unroll
        for (int bj = 0; bj < 2; ++bj)
#pragma unroll
            for (int n = 0; n < 2; ++n) { const f32x4 p0 = p0v[bj][n];
#pragma unroll
                for (int ai = 0; ai < 2; ++ai)
#pragma unroll
                    for (int m = 0; m < 4; ++m) { const f32x4 a = acc[ai][bj][m][n]; f32x4 o; const size_t oo = (size_t)(ai * HALF + m * 16) * RD + bj * HALF + n * 16;
#pragma unroll
                        for (int j = 0; j < 4; ++j) o[j] = osc * sigmoidf_(p0[j] + a[j]);
                        u32x2 w; w.x = cvt_pk_bf16(o[0], o[1]); w.y = cvt_pk_bf16(o[2], o[3]); *(u32x2*)(Ob + oo) = w; } }
        return false;
    }
};
struct ProjTailSched {
    int c, nt;
    __device__ bool next(int i, Unit& u) const { if (i > 0) return false; u.pm = c; u.pn = (NINP / 256) - 1; u.koff = 0; u.nt = nt; u.tag = 0; return true; }
};
struct BranchSched : StaticOrder {
    int nt0;
    __device__ bool next(int i, Unit& u) const { if (!map(i >> 1, u.pm, u.pn)) return false; u.tag = i & 1; u.koff = u.tag == 0 ? RD : 0; u.nt = u.tag == 0 ? nt0 : 2 * nt0; return true; }
};
struct LoraSched : StaticOrder {
    int nt;
    __device__ bool next(int i, Unit& u) const { if (!map(i, u.pm, u.pn)) return false; u.tag = u.pn >> 2; u.koff = u.tag == 0 ? 0 : (u.tag <= 2 ? 256 : 448); u.nt = nt; return true; }
};
}

#define XB_TMO      128
#define XB_XCNT(j)  (256  + 64 * (j))
#define XB_XSUB(j)  (1280 + 64 * (j))
#define XB_XGEN(j)  (2304 + 64 * (j))
#define XB_TOP      3328
#define XB_TOPGEN   3392
#define XCD_BAR_WORDS 3456
#define XB_SPIN_CAP (1u << 21)
__device__ __forceinline__ unsigned xb_ld(unsigned* p)              { return __hip_atomic_load(p, __ATOMIC_RELAXED, __HIP_MEMORY_SCOPE_AGENT); }
__device__ __forceinline__ unsigned xb_add(unsigned* p, unsigned v) { return __hip_atomic_fetch_add(p, v, __ATOMIC_RELAXED, __HIP_MEMORY_SCOPE_AGENT); }
__device__ __forceinline__ unsigned xb_xcc_id() { return (unsigned)__builtin_amdgcn_s_getreg((3 << 11) | 20) & 0xFu; }
#define XB_SPIN(cond, bar) do { unsigned _sp = 0; while (cond) { __builtin_amdgcn_s_sleep(1); \
    if ((++_sp & 255u) == 0u) { if (xb_ld(&(bar)[XB_TMO])) break; if (_sp > XB_SPIN_CAP) { atomicAdd(&(bar)[XB_TMO], 1u); break; } } } } while (0)
struct XcdBarrier { unsigned* bar; unsigned x; volatile LAS unsigned* st; };
__device__ __forceinline__ XcdBarrier xcd_barrier_post(unsigned* bar, volatile LAS unsigned* st) {
    XcdBarrier b; b.bar = bar; b.x = xb_xcc_id(); b.st = st;
    if (threadIdx.x == 0) (void)xb_add(&bar[XB_XCNT(b.x)], 1u);
    return b;
}
__device__ __forceinline__ void xcd_barrier_complete(unsigned* bar, unsigned x, unsigned& nloc, unsigned& nx) {
    const unsigned G = gridDim.x * gridDim.y * gridDim.z;
    unsigned sum, cnt, mine, sp = 0u;
    for (;;) {
        sum = 0u; cnt = 0u; mine = 0u;
#pragma unroll
        for (unsigned j = 0; j < 16; ++j) { const unsigned c = xb_ld(&bar[XB_XCNT(j)]); sum += c; cnt += (c > 0u) ? 1u : 0u; mine = (j == x) ? c : mine; }
        if (sum == G) break;
        __builtin_amdgcn_s_sleep(1);
        if ((++sp & 255u) == 0u) { if (xb_ld(&bar[XB_TMO])) break; if (sp > XB_SPIN_CAP) { atomicAdd(&bar[XB_TMO], 1u); break; } }
    }
    nloc = mine > 0u ? mine : 1u; nx = cnt > 0u ? cnt : 1u;
}
__device__ __forceinline__ void xcd_barrier(const XcdBarrier& b) {
    asm volatile("s_waitcnt vmcnt(0)" ::: "memory");
    __syncthreads();
    if (threadIdx.x == 0) {
        unsigned* bar = b.bar;
        __builtin_amdgcn_s_waitcnt(0);
        unsigned nloc = b.st[0], nx = b.st[1];
        if (nloc == 0u) { xcd_barrier_complete(bar, b.x, nloc, nx); b.st[0] = nloc; b.st[1] = nx; }
        const unsigned old = xb_add(&bar[XB_XSUB(b.x)], 1u);
        const unsigned gen = old / nloc;
        if (old + 1u == (gen + 1u) * nloc) {
            __builtin_amdgcn_fence(__ATOMIC_RELEASE, "agent");
            asm volatile("s_waitcnt vmcnt(0)" ::: "memory");
            const unsigned og = xb_add(&bar[XB_TOP], 1u);
            const unsigned tg = og / nx;
            if (og + 1u == (tg + 1u) * nx) xb_add(&bar[XB_TOPGEN], 1u);
            else XB_SPIN(xb_ld(&bar[XB_TOPGEN]) == tg, bar);
            __builtin_amdgcn_fence(__ATOMIC_ACQUIRE, "agent");
            xb_add(&bar[XB_XGEN(b.x)], 1u);
            asm volatile("s_waitcnt vmcnt(0)" ::: "memory");
        } else {
            XB_SPIN(xb_ld(&bar[XB_XGEN(b.x)]) == gen, bar);
            __builtin_amdgcn_fence(__ATOMIC_ACQUIRE, "agent");
            asm volatile("s_waitcnt vmcnt(0)" ::: "memory");
        }
    }
    __syncthreads();
}

#define XB_EXIT 3520
__device__ unsigned g_bar[4096];
struct Args {
    const float* in[22]; float* out; unsigned char* ws; int ph_lo, ph_hi;
};
struct Frame {
    LAS unsigned char* lds; int tid, lane, wave, G, gw, NGW, bx;
    unsigned char* ws;
};

template <class T> __device__ __forceinline__ T* launder(T* p) {
    unsigned long long v = (unsigned long long)p; unsigned lo = __builtin_amdgcn_readfirstlane((unsigned)v), hi = __builtin_amdgcn_readfirstlane((unsigned)(v >> 32));
    asm volatile("" : "+s"(lo), "+s"(hi)); return (T*)(GAS T*)(((unsigned long long)hi << 32) | lo);
}
__device__ __forceinline__ float wave_sum(float v) {
#pragma unroll
    for (int o = 1; o < 64; o <<= 1) v += __shfl_xor(v, o);
    return v;
}

struct TJob { const float* W; bf16_t* WT; const float* ksc; int N, ldk, n_split, n_shift, k0, n0; bool ok; };
__device__ __forceinline__ TJob tjob(const float* W, int N, bf16_t* WT, int ldk, int n_split, int n_shift, const float* ksc, int item) {
    const int nblk = N / 32, kb = item / nblk, nb = item % nblk; return TJob{W, WT, ksc, N, ldk, n_split, n_shift, 64 * kb, 32 * nb, true}; }
__device__ __forceinline__ void t_load(const TJob& j, f32x4 (&w)[8], float (&g)[8], int lane) {
    const int kr = lane >> 3, nq = (lane & 7) * 4;
#pragma unroll
    for (int i = 0; i < 8; ++i) w[i] = __builtin_nontemporal_load((const f32x4*)(j.W + (size_t)(j.k0 + kr + 8 * i) * j.N + j.n0 + nq));
    if (j.ksc) {
#pragma unroll
        for (int i = 0; i < 8; ++i) g[i] = j.ksc[j.k0 + kr + 8 * i]; }
    else {
#pragma unroll
        for (int i = 0; i < 8; ++i) g[i] = 1.0f; }
}
__device__ __forceinline__ void t_finish(const TJob& j, const f32x4 (&w)[8], const float (&g)[8], LAS float* scr, int lane) {
    { const int kr = lane >> 3, nq = (lane & 7) * 4;
#pragma unroll
      for (int i = 0; i < 8; ++i) { const int kk = kr + 8 * i; const f32x4 v = w[i] * g[i];
          scr[kk * 33 + nq] = v[0]; scr[kk * 33 + nq + 1] = v[1]; scr[kk * 33 + nq + 2] = v[2]; scr[kk * 33 + nq + 3] = v[3]; } }
    asm volatile("s_waitcnt lgkmcnt(0)" ::: "memory");
    const int c = lane & 7;
#pragma unroll
    for (int q = 0; q < 4; ++q) { const int n = (lane >> 3) + 8 * q; const LAS float* sp = scr + (8 * c) * 33 + n;
        u32x4 o; o.x = cvt_pk_bf16(sp[0 * 33], sp[1 * 33]); o.y = cvt_pk_bf16(sp[2 * 33], sp[3 * 33]); o.z = cvt_pk_bf16(sp[4 * 33], sp[5 * 33]); o.w = cvt_pk_bf16(sp[6 * 33], sp[7 * 33]);
        const int nn = j.n0 + n; const int nr = nn < j.n_split ? nn : nn + j.n_shift;
        __builtin_nontemporal_store(o, (u32x4*)(j.WT + (size_t)nr * j.ldk + j.k0 + 8 * c)); }
    asm volatile("s_waitcnt lgkmcnt(0)" ::: "memory");
}
template <class Dec>
__device__ __forceinline__ void t_stream(const Dec& dec, LAS float* scr, int lane) {
    int n = 0; TJob ja = dec(n); if (!ja.ok) return;
    f32x4 wa[8], wb[8]; float ga[8], gb[8];
    t_load(ja, wa, ga, lane);
    for (;;) {
        const TJob jb = dec(n + 1); if (jb.ok) t_load(jb, wb, gb, lane);
        t_finish(ja, wa, ga, scr, lane);
        if (!jb.ok) break;
        ja = dec(n + 2); if (ja.ok) t_load(ja, wa, ga, lane);
        t_finish(jb, wb, gb, scr, lane);
        if (!ja.ok) break;
        n += 2;
    }
}
__device__ __forceinline__ int t5_bucket(int rel) {
    const int ret = rel > 0 ? 16 : 0; const int n = rel < 0 ? -rel : rel;
    if (n < 8) return ret + n;
    int large = 8 + (int)(logf((float)n / 8.0f) / 4.852030263919617f * 8.0f);
    if (large > 15) large = 15;
    return ret + large;
}
__device__ __forceinline__ void convert_weights(const Args& AR, unsigned char* ws, int l, int sel, int wi, int nw, LAS float* scr, int lane, int q0, int q1, int wcount = 1, int ewi = -1, int enw = 0) {
    const int qc = q1 - q0;
    if (ewi < 0) { ewi = wi; enw = nw; }
    unsigned char* wl = ws + WS_W + (size_t)l * W_LAYER_B;
    constexpr int I_IN = (DM / 64) * (NIN / 32), I_BR = (RD / 64) * (DM / 32), I_BA = (AOD / 64) * (DM / 32), I_OUT = (DM / 64) * (DM / 32), I_MI = (DM / 64) * (DFF / 32), I_MO = (DFF / 64) * (DM / 32);
    if (sel & 1) {
        const float* w_in = AR.in[2] + (size_t)l * DM * NIN; const float* n1 = AR.in[1] + l * DM;
        t_stream([&](int n) { const int sx = wi + (n / wcount) * nw + (n % wcount); const int it = (sx / qc) * 8 + q0 + (sx % qc);
                      if (it >= I_IN) { TJob z{}; z.ok = false; return z; }
                      return tjob(w_in, NIN, (bf16_t*)(wl + WO_IN), DM, RWKV_COLS, SLABP - RWKV_COLS, n1, it); }, scr, lane);
        const int gt = ewi * 64 + lane, nth = enw * 64;
        if (q1 == 8) { bf16_t* z = (bf16_t*)(wl + WO_IN) + (size_t)RWKV_COLS * DM;
          unsigned zz; asm volatile("v_mov_b32 %0, 0" : "=v"(zz));
          for (int i = gt; i < (SLABP - RWKV_COLS) * DM / 8; i += nth) *(u32x4*)(z + (size_t)i * 8) = (u32x4){zz, zz, zz, zz}; }
        if (q1 == 8) { bf16_t* Bl = (bf16_t*)(wl + WO_LORA);
          const float* gup = AR.in[8] + (size_t)l * 256 * RD; const float* wup = AR.in[5] + (size_t)l * 2 * 96 * RD; const float* aup = AR.in[7] + (size_t)l * 2 * 96 * RD;
          for (int i = gt; i < LORA_N * (LORA_K / 8); i += nth) {
              const int kc = i / LORA_N, n = i % LORA_N, cb = n >> 10, c = n & 1023, k0 = kc * 8;
              const int lo = cb == 0 ? 0 : 160 + 96 * cb, len = cb == 0 ? 256 : 96;
              const float* src = cb == 0 ? gup : (cb < 3 ? wup + (size_t)(cb - 1) * 96 * RD : aup + (size_t)(cb - 3) * 96 * RD);
              u32x4 o = (u32x4){0u, 0u, 0u, 0u};
              if (k0 >= lo && k0 < lo + len) { const float* sp = src + (size_t)(k0 - lo) * RD + c; float f[8];
#pragma unroll
                  for (int j = 0; j < 8; ++j) f[j] = sp[(size_t)j * RD];
                  o = pack8(f); }
              *(u32x4*)(Bl + (size_t)n * LORA_K + k0) = o; } }
    }
    if (sel & 2) {
        const float* wbr = AR.in[15] + (size_t)l * RD * DM; const float* wba = AR.in[16] + (size_t)l * AOD * DM; const float* wout = AR.in[17] + (size_t)l * DM * DM;
        const float* n2 = AR.in[18] + l * DM; const float* wmi = AR.in[19] + (size_t)l * DM * DFF; const float* wmo = AR.in[20] + (size_t)l * DFF * DM;
        constexpr int NITEMS = I_BR + I_BA + I_OUT + I_MI + I_MO;
        t_stream([&](int n) { const int sx = wi + (n / wcount) * nw + (n % wcount); const int it = (sx / qc) * 8 + q0 + (sx % qc);
                      if (it >= NITEMS) { TJob z{}; z.ok = false; return z; }
                      int r = it;
                      if (r < I_BR) return tjob(wbr, DM, (bf16_t*)(wl + WO_BR), OCAT, 1 << 30, 0, nullptr, r); r -= I_BR;
                      if (r < I_BA) return tjob(wba, DM, (bf16_t*)(wl + WO_BR) + RD, OCAT, 1 << 30, 0, nullptr, r); r -= I_BA;
                      if (r < I_OUT) return tjob(wout, DM, (bf16_t*)(wl + WO_OUT), DM, 1 << 30, 0, nullptr, r); r -= I_OUT;
                      if (r < I_MI) return tjob(wmi, DFF, (bf16_t*)(wl + WO_MI), DM, 1 << 30, 0, n2, r); r -= I_MI;
                      return tjob(wmo, DM, (bf16_t*)(wl + WO_MO), DFF, 1 << 30, 0, nullptr, r); }, scr, lane);
    }
}
__device__ __forceinline__ void p0_prologue(const Args& AR, Frame& F) {
    convert_weights(AR, F.ws, 0, 1, F.gw, F.NGW, (LAS float*)(F.lds + F.wave * 16384), F.lane, 0, 8);
    const float* x = AR.in[0]; bf16_t* HB = (bf16_t*)(F.ws + WS_ACT + A_HB); u64* ssqA = (u64*)(F.ws + WS_SSQA);
    for (int m = F.gw; m < M; m += F.NGW) {
        const f32x4* xr = (const f32x4*)(x + (size_t)m * DM) + F.lane; float s = 0.f; f32x4 xv[8];
#pragma unroll
        for (int j = 0; j < 8; ++j) xv[j] = xr[64 * j];
#pragma unroll
        for (int j = 0; j < 8; ++j) { const f32x4 v = xv[j]; s += (v[0] * v[0] + v[1] * v[1]) + (v[2] * v[2] + v[3] * v[3]);
            u32x2 w; w.x = cvt_pk_bf16(v[0], v[1]); w.y = cvt_pk_bf16(v[2], v[3]); *(u32x2*)(HB + (size_t)m * DM + (64 * j + F.lane) * 4) = w; }
        s = wave_sum(s); if (F.lane == 0) ssqA[m] = (u64)(s * 16777216.0f + 0.5f);
    }
    if (F.bx == 0) { float* bt = (float*)(F.ws + WS_BTAB); const float* rb = AR.in[14];
        for (int i = F.tid; i < AH * 256; i += NTHREADS) { const int h = i >> 8, j = (i & 255) - 64, g = h >> 3, dil = g == 0 ? 1 : (g == 1 ? 4 : 16);
            bt[i] = (j >= 0 && j <= 128) ? rb[t5_bucket((j - 64) * dil) * AH + h] : 0.f; } }
}

__device__ __forceinline__ void phase_shift(const Args& AR, Frame& F, int l) {
    const bf16_t* proj = (const bf16_t*)(F.ws + WS_ACT + A_PROJ);
    bf16_t* R = (bf16_t*)(F.ws + WS_ACT + A_R); bf16_t* K = (bf16_t*)(F.ws + WS_ACT + A_K); bf16_t* V = (bf16_t*)(F.ws + WS_ACT + A_V); bf16_t* KK = (bf16_t*)(F.ws + WS_ACT + A_KK);
    bf16_t* LIN = (bf16_t*)(F.ws + WS_ACT + A_LIN);
    const float* mu = AR.in[3] + (size_t)l * RWKV_COLS; const float* k_k = AR.in[9] + (size_t)l * RD;
    f32x4 muv[8][2], kkv[2][2];
#pragma unroll
    for (int j = 0; j < 8; ++j) { const int cl = min(F.lane + 64 * j, 463) * 8; muv[j][0] = *(const f32x4*)(mu + cl); muv[j][1] = *(const f32x4*)(mu + cl + 4); }
#pragma unroll
    for (int j = 0; j < 2; ++j) { const int cc = ((F.lane + 64 * (2 + j)) & 127) * 8; kkv[j][0] = *(const f32x4*)(k_k + cc); kkv[j][1] = *(const f32x4*)(k_k + cc + 4); }
    for (int m = F.gw; m < M; m += F.NGW) {
        const int t = m % SEQ; const float fp = t > 0 ? 0.5f : 0.f, fn = t < SEQ - 1 ? 0.5f : 0.f;
        const bf16_t* row = proj + (size_t)m * NINP; const bf16_t* prow = t > 0 ? row - NINP : row; const bf16_t* nrow = t < SEQ - 1 ? row + NINP : row;
        u32x4 cw[8], pw[8], nw[8];
#pragma unroll
        for (int j = 0; j < 8; ++j) { const int cl = min(F.lane + 64 * j, 463) * 8; cw[j] = *(const u32x4*)(row + cl); pw[j] = *(const u32x4*)(prow + cl); nw[j] = *(const u32x4*)(nrow + cl); }
#pragma unroll
        for (int j = 0; j < 8; ++j) { const int ci = F.lane + 64 * j;
            if (j < 7 || ci < 464) {
                float c[8], p[8], nx[8], o[8]; unpack8(cw[j], c); unpack8(pw[j], p); unpack8(nw[j], nx);
                const f32x4 m0 = muv[j][0], m1 = muv[j][1];
#pragma unroll
                for (int e = 0; e < 8; ++e) { const float mm = e < 4 ? m0[e] : m1[e - 4]; o[e] = c[e] + mm * ((fp * p[e] + fn * nx[e]) - c[e]); }
                if (j < 6) {
                    const int cc = (ci & 127) * 8; bf16_t* dst = (j < 2 ? R : (j < 4 ? K : V)) + (size_t)m * RD + cc;
                    *(u32x4*)dst = pack8(o);
                    if (j == 2 || j == 3) {
                        const f32x4 q0 = kkv[j - 2][0], q1 = kkv[j - 2][1]; float tt[8], ss = 0.f;
#pragma unroll
                        for (int e = 0; e < 8; ++e) { tt[e] = o[e] * (e < 4 ? q0[e] : q1[e - 4]); ss += tt[e] * tt[e]; }
                        ss += __shfl_xor(ss, 1); ss += __shfl_xor(ss, 2); ss += __shfl_xor(ss, 4);
                        const float inv = 1.0f / fmaxf(sqrtf(ss), 1e-12f);
                        bf16_t* kd = KK + (size_t)m * RD + cc;
#pragma unroll
                        for (int e = 0; e < 8; ++e) tt[e] *= inv;
                        *(u32x4*)kd = pack8(tt);
                    }
                } else {
                    const int lc = (ci - 384) * 8;
                    float f[8];
#pragma unroll
                    for (int e = 0; e < 8; ++e) f[e] = ci < 416 ? sigmoidf_(o[e]) : (ci < 440 ? tanhf(o[e]) : o[e]);
                    *(u32x4*)(LIN + (size_t)m * LORA_K + lc) = pack8(f);
                }
            } else if (ci < 480) { *(u32x4*)(LIN + (size_t)m * LORA_K + (ci - 384) * 8) = (u32x4){0u, 0u, 0u, 0u}; }
        }
    }
    { LAS bf16_t* T = (LAS bf16_t*)(F.lds + F.wave * 16640);
      bf16_t* VT = (bf16_t*)(F.ws + WS_ACT + A_VT);
      for (int it = F.gw; it < BATCH * AH * 32; it += F.NGW) {
          const int tile = it & 31, head = (it >> 5) % AH, b = it / (32 * AH), g = head >> 3, dil = g == 0 ? 1 : (g == 1 ? 4 : 16), L = SEQ / dil;
          const bf16_t* src = proj + (size_t)(b * SEQ + tile * 128) * NINP + VOFF + head * HD;
#pragma unroll 4
          for (int i = 0; i < 16; ++i) { const int tl = 8 * i + (F.lane >> 3), dc = F.lane & 7; const u32x4 w = *(const u32x4*)(src + (size_t)tl * NINP + dc * 8);
              const unsigned ww[4] = {w.x, w.y, w.z, w.w};
#pragma unroll
              for (int e = 0; e < 8; ++e) T[(dc * 8 + e) * 130 + tl] = (bf16_t)((e & 1) ? (ww[e >> 1] >> 16) : (ww[e >> 1] & 0xffffu)); }
          asm volatile("s_waitcnt lgkmcnt(0)" ::: "memory");
          const int P = 128 / dil, cpr = P / 8;
#pragma unroll 4
          for (int i = 0; i < 16; ++i) { const int q = i * 64 + F.lane, d = q >> 4, oc = q & 15, rr = oc / cpr, pc = oc % cpr; unsigned short e8[8];
#pragma unroll
              for (int e = 0; e < 8; ++e) { const int q = (pc & 1) * 8 + e, sp = dil == 16 ? e : (pc >> 1) * 16 + ((q & 3) | ((q & 8) >> 1) | ((q & 4) << 1));
                  e8[e] = T[d * 130 + sp * dil + rr]; }
              u32x4 w; w.x = e8[0] | ((unsigned)e8[1] << 16); w.y = e8[2] | ((unsigned)e8[3] << 16); w.z = e8[4] | ((unsigned)e8[5] << 16); w.w = e8[6] | ((unsigned)e8[7] << 16);
              bf16_t* vrow = VT + ((size_t)(b * AH + head) * HD + d) * SEQ + (size_t)rr * L;
              if (dil == 16) { bf16_t* gp = vrow + (tile >> 1) * 16 + 4 * (tile & 1);
                  *(u32x2*)gp = (u32x2){w.x, w.y}; *(u32x2*)(gp + 8) = (u32x2){w.z, w.w}; }
              else *(u32x4*)(vrow + tile * P + pc * 8) = w; }
          asm volatile("s_waitcnt lgkmcnt(0)" ::: "memory");
      } }
}

__device__ __forceinline__ void phase_attn(Frame& F, int aw, int naw) {
    const bf16_t* proj = (const bf16_t*)(F.ws + WS_ACT + A_PROJ); const bf16_t* VT = (const bf16_t*)(F.ws + WS_ACT + A_VT);
    const float* btab = (const float*)(F.ws + WS_BTAB);
    bf16_t* OG = (bf16_t*)(F.ws + WS_ACT + A_OG); float* LSE = (float*)(F.ws + WS_ACT + A_LSE);
    const int lane = F.lane, c32 = lane & 31, h = lane >> 5;
    for (int task = aw; task < BATCH * AH * 128; task += naw) {
        const int qt = task & 127, head = (task >> 7) % AH, b = task / (128 * AH), g = head >> 3, dil = g == 0 ? 1 : (g == 1 ? 4 : 16), L = SEQ / dil;
        const int s0 = qt * 32, r = s0 / L, pos0 = s0 % L;
        const bf16_t* base = proj + (size_t)b * SEQ * NINP + head * HD;
        f32x16 sc[5];
        { typedef float f32x4u __attribute__((ext_vector_type(4), aligned(4)));
          const float* bt = btab + head * 256 + 64 + 4 * h - c32;
#pragma unroll
          for (int kt = 0; kt < 5; ++kt)
#pragma unroll
              for (int g4 = 0; g4 < 4; ++g4) { const f32x4u bv = *(const f32x4u*)(bt + 32 * kt + 8 * g4);
#pragma unroll
                  for (int e = 0; e < 4; ++e) sc[kt][4 * g4 + e] = bv[e]; } }
        __builtin_amdgcn_sched_barrier(0);
        bf16x8 qf[4];
        { const bf16_t* qp = base + (size_t)((pos0 + c32) * dil + r) * NINP + QOFF + 8 * h;
#pragma unroll
          for (int s = 0; s < 4; ++s) qf[s] = *(const bf16x8*)(qp + 16 * s); }
        bf16x8 kfr[5][4];
#define LOAD_K(kt) do { const int kp_ = pos0 - 64 + 32 * (kt) + c32; const int kpc_ = kp_ < 0 ? 0 : (kp_ >= L ? L - 1 : kp_); const unsigned ko_ = (unsigned)((kpc_ * dil + r) * NINP + KOFF + 8 * h) * 2u; \
            _Pragma("unroll") for (int s_ = 0; s_ < 4; ++s_) kfr[kt][s_] = *(const bf16x8*)((const char*)base + (ko_ + 32u * s_)); } while (0)
        LOAD_K(0); LOAD_K(1); LOAD_K(2);
        const char* vth = (const char*)(VT + (size_t)(b * AH + head) * HD * SEQ);
        const unsigned vo0 = (unsigned)(c32 * SEQ + r * L) * 2u, vo1 = vo0 + 32u * SEQ * 2u;
        u32x4 vfa[10], vfb[10];
#define LOAD_V(ks) do { int k0 = pos0 - 64 + 16 * (ks);                                            \
            k0 = (k0 < 0 || k0 >= L) ? 0 : k0; \
            vfa[ks] = *(const u32x4*)(vth + (vo0 + 2u * k0 + 16u * h)); vfb[ks] = *(const u32x4*)(vth + (vo1 + 2u * k0 + 16u * h)); } while (0)
#pragma unroll
        for (int ks = 0; ks < 2; ++ks) LOAD_V(ks);
        __builtin_amdgcn_sched_barrier(0);
#pragma unroll
        for (int kt = 0; kt < 5; ++kt)
#pragma unroll
            for (int i = 0; i < 16; ++i) { const int krow = (i & 3) + 8 * (i >> 2) + 4 * h, kpos = pos0 - 64 + 32 * kt + krow, idx = 32 * kt + krow - c32;
                const bool ok = (idx >= 0) && (idx <= 128) && (kpos >= 0) && (kpos < L);
                sc[kt][i] = ok ? sc[kt][i] : -INFINITY; }
#pragma unroll
        for (int kt = 0; kt < 5; ++kt) {
            if (kt == 0) { LOAD_K(3); } if (kt == 1) { LOAD_K(4); }
            f32x16 a = sc[kt];
#pragma unroll
            for (int s = 0; s < 4; ++s) a = __builtin_amdgcn_mfma_f32_32x32x16_bf16(kfr[kt][s], qf[s], a, 0, 0, 0);
            sc[kt] = a;
        }
#pragma unroll
        for (int ks = 2; ks < 6; ++ks) LOAD_V(ks);
#undef LOAD_K
        __builtin_amdgcn_sched_barrier(0);
        float mx = -INFINITY;
#pragma unroll
        for (int kt = 0; kt < 5; ++kt)
#pragma unroll
            for (int i = 0; i < 16; ++i) mx = fmaxf(mx, sc[kt][i]);
        mx = fmaxf(mx, __shfl_xor(mx, 32));
        float lsum = 0.f;
#pragma unroll
        for (int kt = 0; kt < 5; ++kt)
#pragma unroll
            for (int i = 0; i < 16; ++i) { const float p = __expf(sc[kt][i] - mx); sc[kt][i] = p; lsum += p; }
        lsum += __shfl_xor(lsum, 32);
        f32x16 o0 = {}, o1 = {};
#pragma unroll
        for (int kt = 0; kt < 5; ++kt)
#pragma unroll
            for (int s = 0; s < 2; ++s) {
                if (kt == 0 && s == 0) { LOAD_V(6); LOAD_V(7); } if (kt == 1 && s == 0) { LOAD_V(8); LOAD_V(9); }
                u32x4 pw; pw.x = cvt_pk_bf16(sc[kt][8 * s + 0], sc[kt][8 * s + 1]); pw.y = cvt_pk_bf16(sc[kt][8 * s + 2], sc[kt][8 * s + 3]); pw.z = cvt_pk_bf16(sc[kt][8 * s + 4], sc[kt][8 * s + 5]); pw.w = cvt_pk_bf16(sc[kt][8 * s + 6], sc[kt][8 * s + 7]);
                const bf16x8 pf = __builtin_bit_cast(bf16x8, pw);
                o0 = __builtin_amdgcn_mfma_f32_32x32x16_bf16(__builtin_bit_cast(bf16x8, vfa[2 * kt + s]), pf, o0, 0, 0, 0);
                o1 = __builtin_amdgcn_mfma_f32_32x32x16_bf16(__builtin_bit_cast(bf16x8, vfb[2 * kt + s]), pf, o1, 0, 0, 0);
            }
#undef LOAD_V
        const float inv = 1.0f / lsum;
        const size_t tok = (size_t)b * SEQ + (size_t)(pos0 + c32) * dil + r; const int slot = head & 7;
        bf16_t* op = OG + ((size_t)g * M + tok) * AOD + slot * HD + 4 * h;
#pragma unroll
        for (int q4 = 0; q4 < 4; ++q4) { u32x2 w0, w1;
            w0.x = cvt_pk_bf16(o0[4 * q4] * inv, o0[4 * q4 + 1] * inv); w0.y = cvt_pk_bf16(o0[4 * q4 + 2] * inv, o0[4 * q4 + 3] * inv);
            w1.x = cvt_pk_bf16(o1[4 * q4] * inv, o1[4 * q4 + 1] * inv); w1.y = cvt_pk_bf16(o1[4 * q4 + 2] * inv, o1[4 * q4 + 3] * inv);
            *(u32x2*)(op + 8 * q4) = w0; *(u32x2*)(op + 32 + 8 * q4) = w1; }
        if (h == 0) LSE[((size_t)g * M + tok) * 8 + slot] = mx + __logf(lsum);
    }
}

__device__ __forceinline__ unsigned cvtpk(float lo, float hi) { return cvt_pk_bf16(lo, hi); }
__device__ __forceinline__ bf16x8 pack8v(float a0, float a1, float a2, float a3, float a4, float a5, float a6, float a7) { u32x4 w; w.x = cvtpk(a0, a1); w.y = cvtpk(a2, a3); w.z = cvtpk(a4, a5); w.w = cvtpk(a6, a7); return __builtin_bit_cast(bf16x8, w); }
__device__ __forceinline__ bf16x8 acc_frag(const f32x16& a, int ks) { return ks == 0 ? pack8v(a[0], a[1], a[2], a[3], a[4], a[5], a[6], a[7]) : pack8v(a[8], a[9], a[10], a[11], a[12], a[13], a[14], a[15]); }
#define SCAN_TOK(s_) (dir ? (SEQ - 1 - (c * SCT + (s_))) : (c * SCT + (s_)))
typedef short v4i16_t __attribute__((ext_vector_type(4)));
__device__ __forceinline__ bf16x8 tr_frag(const LAS unsigned char* p0, const LAS unsigned char* p1) {
    const v4i16_t lo = __builtin_amdgcn_ds_read_tr16_b64_v4i16((LAS v4i16_t*)p0), hi = __builtin_amdgcn_ds_read_tr16_b64_v4i16((LAS v4i16_t*)p1);
    return (bf16x8){lo[0], lo[1], lo[2], lo[3], hi[0], hi[1], hi[2], hi[3]};
}
__device__ __forceinline__ void phase_scan_prep(Frame& F, const float* k_a, const float* r_k) {
    unsigned char* act = F.ws + WS_ACT;
    const bf16_t* R = (const bf16_t*)(act + A_R); const bf16_t* V = (const bf16_t*)(act + A_V); const bf16_t* KK = (const bf16_t*)(act + A_KK);
    LAS float* Cb = (LAS float*)(F.lds + F.wave * 17152);
    LAS float* Lm = Cb + 33 * 64;
    LAS float* X = Lm + 32 * 32;
    LAS float* RKl = (LAS float*)(F.lds + PARAM_OFF + F.wave * 512); LAS float* KAl = RKl + 64;
    constexpr int TS = 136;
    LAS unsigned char* TB = (LAS unsigned char*)Lm; LAS unsigned char* TK = TB + 32 * TS; LAS unsigned char* TV = (LAS unsigned char*)Cb;
    for (int vi = F.gw * 2; vi < BATCH * RH * 2 * NCHUNK; vi += (vi & 1) ? 2 * F.NGW - 1 : 1) {
        const int pr = vi >> 1, pdir = vi & 1, pc0 = pr & (NCHUNK - 1);
        const int inst = (((pr >> 7) * 2 + pdir) << 7) + (pdir ? NCHUNK - 1 - pc0 : pc0);
        int lane = F.lane; asm volatile("" : "+v"(lane));
        const int c32 = lane & 31, h = lane >> 5;
        const int trb = ((lane & 15) >> 2) * TS + (16 * ((lane >> 4) & 1) + 4 * (lane & 3)) * 2 + 4 * h * TS;
        const int c = inst & (NCHUNK - 1), dir = (inst >> 7) & 1, hh = (inst >> 8) & 15, b = inst >> 12;
        const bf16_t* W = (const bf16_t*)(act + (dir ? A_WB : A_WF)); const bf16_t* AA = (const bf16_t*)(act + (dir ? A_AB : A_AF)); const bf16_t* Kr = (const bf16_t*)(act + A_K); const float* kah = k_a + hh * HD; const float* rkh = r_k + hh * HD;
        unsigned char* fr = act + A_FR + (size_t)inst * FR_STRIDE + lane * 16;
        const size_t hb = (size_t)b * SEQ * RD + hh * HD;
#define ST_FRAG(idx, v) __builtin_nontemporal_store((v), (bf16x8*)(fr + (idx) * 1024))
#define UP4(w) ((f32x4){bf_lo((w).x), bf_hi((w).x), bf_lo((w).y), bf_hi((w).y)})
        float wv[SCT];
#pragma unroll
        for (int t = 0; t < SCT; ++t) wv[t] = bf_lo((unsigned)(W + hb + (size_t)SCAN_TOK(t) * RD)[lane]);
        const bf16_t* KKb = KK + hb; const bf16_t* AAb = AA + hb; const bf16_t* Krb = Kr + hb; const bf16_t* Rb = R + hb; const bf16_t* Vb = V + hb;
        const int rb = SCAN_TOK(c32) * RD;
        u32x2 nk[4][2], na[4][2], nr_[4][2], nq[4][2], nv[4][2];
#pragma unroll
        for (int q = 0; q < 4; ++q) { const int j0 = 16 * q + 8 * h;
#pragma unroll
            for (int e = 0; e < 2; ++e) { nk[q][e] = *(const u32x2*)(KKb + rb + j0 + 4 * e); na[q][e] = *(const u32x2*)(AAb + rb + j0 + 4 * e); nr_[q][e] = *(const u32x2*)(Krb + rb + j0 + 4 * e); nq[q][e] = *(const u32x2*)(Rb + rb + j0 + 4 * e);
                nv[q][e] = *(const u32x2*)(Vb + rb + j0 + 4 * e); } }
        const float rkv = rkh[lane], kav = kah[lane];
        __builtin_amdgcn_sched_barrier(0);
        { float cum = 0.f; Cb[lane] = 1.f; RKl[lane] = rkv; KAl[lane] = kav;
#pragma unroll
          for (int t = 0; t < SCT; ++t) { cum += wv[t]; Cb[(t + 1) * 64 + lane] = __builtin_amdgcn_exp2f(cum); } }
        asm volatile("s_waitcnt lgkmcnt(0)" ::: "memory");
        { float bsum = 0.f;
#pragma unroll
          for (int q = 0; q < 4; ++q) { const int j0 = 16 * q + 8 * h;
              u32x2 wq0 = nq[q][0], wq1 = nq[q][1], wk0 = nr_[q][0], wk1 = nr_[q][1], wa0 = na[q][0], wa1 = na[q][1];
              asm volatile("" : "+v"(wq0), "+v"(wq1), "+v"(wk0), "+v"(wk1), "+v"(wa0), "+v"(wa1));
              const f32x4 r0 = UP4(wq0), r1 = UP4(wq1), k0 = UP4(wk0), k1 = UP4(wk1), a0 = UP4(wa0), a1 = UP4(wa1);
              const f32x4 ka0 = *(const LAS f32x4*)(KAl + j0), ka1 = *(const LAS f32x4*)(KAl + j0 + 4), rk0 = *(const LAS f32x4*)(RKl + j0), rk1 = *(const LAS f32x4*)(RKl + j0 + 4);
              const f32x4 t0 = r0 * (k0 * (1.0f + (a0 - 1.0f) * ka0)) * rk0, t1 = r1 * (k1 * (1.0f + (a1 - 1.0f) * ka1)) * rk1;
              bsum += (t0[0] + t0[1]) + (t0[2] + t0[3]) + (t1[0] + t1[1]) + (t1[2] + t1[3]); }
          bsum += __shfl_xor(bsum, 32);
          if (h == 0) ((float*)(act + A_BS))[((size_t)dir * M + (size_t)b * SEQ + SCAN_TOK(c32)) * RH + hh] = bsum; }
        __builtin_amdgcn_sched_barrier(0);
        bf16x8 Pb[4], Pk[4], Qa[4], Qr[4];
#pragma unroll
        for (int q = 0; q < 4; ++q) { const int j0 = 16 * q + 8 * h;
            const f32x4 k0 = UP4(nk[q][0]), k1 = UP4(nk[q][1]), av0 = UP4(na[q][0]), av1 = UP4(na[q][1]), kr0 = UP4(nr_[q][0]), kr1 = UP4(nr_[q][1]), r0 = UP4(nq[q][0]), r1 = UP4(nq[q][1]);
            const f32x4 ka0 = *(const LAS f32x4*)(KAl + j0), ka1 = *(const LAS f32x4*)(KAl + j0 + 4);
            const f32x4 a0 = k0 * av0, a1 = k1 * av1, d0 = kr0 * (1.0f + (av0 - 1.0f) * ka0), d1 = kr1 * (1.0f + (av1 - 1.0f) * ka1);
            const f32x4 cc0 = *(const LAS f32x4*)(Cb + (c32 + 1) * 64 + j0), cc1 = *(const LAS f32x4*)(Cb + (c32 + 1) * 64 + j0 + 4), cp0 = *(const LAS f32x4*)(Cb + c32 * 64 + j0), cp1 = *(const LAS f32x4*)(Cb + c32 * 64 + j0 + 4);
            const f32x4 ct0 = *(const LAS f32x4*)(Cb + SCT * 64 + j0), ct1 = *(const LAS f32x4*)(Cb + SCT * 64 + j0 + 4);
            f32x4 i0, i1;
#pragma unroll
            for (int e = 0; e < 4; ++e) { i0[e] = __builtin_amdgcn_rcpf(cc0[e]); i1[e] = __builtin_amdgcn_rcpf(cc1[e]); }
            const f32x4 qa0 = k0 * cp0, qa1 = k1 * cp1, pb0 = a0 * i0, pb1 = a1 * i1, pk0 = d0 * i0, pk1 = d1 * i1, qr0 = r0 * cc0, qr1 = r1 * cc1;
            Qa[q] = pack8v(qa0[0], qa0[1], qa0[2], qa0[3], qa1[0], qa1[1], qa1[2], qa1[3]); Pb[q] = pack8v(pb0[0], pb0[1], pb0[2], pb0[3], pb1[0], pb1[1], pb1[2], pb1[3]);
            Pk[q] = pack8v(pk0[0], pk0[1], pk0[2], pk0[3], pk1[0], pk1[1], pk1[2], pk1[3]); Qr[q] = pack8v(qr0[0], qr0[1], qr0[2], qr0[3], qr1[0], qr1[1], qr1[2], qr1[3]);
            { const f32x4 b0 = pb0 * ct0, b1 = pb1 * ct1, e0 = pk0 * ct0, e1 = pk1 * ct1;
              *(LAS u32x2*)(TB + c32 * TS + j0 * 2) = (u32x2){cvt_pk_bf16(b0[0], b0[1]), cvt_pk_bf16(b0[2], b0[3])}; *(LAS u32x2*)(TB + c32 * TS + j0 * 2 + 8) = (u32x2){cvt_pk_bf16(b1[0], b1[1]), cvt_pk_bf16(b1[2], b1[3])};
              *(LAS u32x2*)(TK + c32 * TS + j0 * 2) = (u32x2){cvt_pk_bf16(e0[0], e0[1]), cvt_pk_bf16(e0[2], e0[3])}; *(LAS u32x2*)(TK + c32 * TS + j0 * 2 + 8) = (u32x2){cvt_pk_bf16(e1[0], e1[1]), cvt_pk_bf16(e1[2], e1[3])}; }
            const int jA = 16 * q + 4 * h, jB = jA + 8;
            const u32x2 sk0 = __builtin_amdgcn_permlane32_swap(nk[q][0].x, nk[q][1].x, false, false), sk1 = __builtin_amdgcn_permlane32_swap(nk[q][0].y, nk[q][1].y, false, false);
            const u32x2 sr0 = __builtin_amdgcn_permlane32_swap(nq[q][0].x, nq[q][1].x, false, false), sr1 = __builtin_amdgcn_permlane32_swap(nq[q][0].y, nq[q][1].y, false, false);
            const f32x4 ka = UP4(((u32x2){sk0.x, sk1.x})), kb = UP4(((u32x2){sk0.y, sk1.y})), ra = UP4(((u32x2){sr0.x, sr1.x})), rbv = UP4(((u32x2){sr0.y, sr1.y}));
            const f32x4 pa = *(const LAS f32x4*)(Cb + c32 * 64 + jA), pbv = *(const LAS f32x4*)(Cb + c32 * 64 + jB), ca = *(const LAS f32x4*)(Cb + (c32 + 1) * 64 + jA), cbv = *(const LAS f32x4*)(Cb + (c32 + 1) * 64 + jB);
            const f32x4 x0 = ka * pa, x1 = kb * pbv, y0 = ra * ca, y1 = rbv * cbv;
            ST_FRAG(FR_AT + q, pack8v(x0[0], x0[1], x0[2], x0[3], x1[0], x1[1], x1[2], x1[3]));
            ST_FRAG(FR_RT + q, pack8v(y0[0], y0[1], y0[2], y0[3], y1[0], y1[1], y1[2], y1[3])); }
        *(float*)(fr - lane * 16 + FR_CT_BYTE + lane * 4) = Cb[SCT * 64 + lane];
        asm volatile("s_waitcnt lgkmcnt(0)" ::: "memory");
#pragma unroll
        for (int q = 0; q < 4; ++q) { const int j0 = 16 * q + 8 * h; *(LAS u32x2*)(TV + c32 * TS + j0 * 2) = nv[q][0]; *(LAS u32x2*)(TV + c32 * TS + j0 * 2 + 8) = nv[q][1]; }
        asm volatile("s_waitcnt lgkmcnt(0)" ::: "memory");
#pragma unroll
        for (int mt = 0; mt < 2; ++mt)
#pragma unroll
            for (int ks = 0; ks < 2; ++ks) { const int o = trb + 16 * ks * TS + 64 * mt;
                ST_FRAG(FR_BP + 2 * mt + ks, tr_frag(TB + o, TB + o + 8 * TS));
                ST_FRAG(FR_KP + 2 * mt + ks, tr_frag(TK + o, TK + o + 8 * TS));
                ST_FRAG(FR_VF + 2 * mt + ks, tr_frag(TV + o, TV + o + 8 * TS)); }
        f32x16 Zba = {}, Zka = {}, Zbr = {}, Zkr = {};
#pragma unroll
        for (int q = 0; q < 4; ++q) { Zba = __builtin_amdgcn_mfma_f32_32x32x16_bf16(Pb[q], Qa[q], Zba, 0, 0, 0); Zka = __builtin_amdgcn_mfma_f32_32x32x16_bf16(Pk[q], Qa[q], Zka, 0, 0, 0);
            Zbr = __builtin_amdgcn_mfma_f32_32x32x16_bf16(Pb[q], Qr[q], Zbr, 0, 0, 0); Zkr = __builtin_amdgcn_mfma_f32_32x32x16_bf16(Pk[q], Qr[q], Zkr, 0, 0, 0); }
        asm volatile("s_waitcnt lgkmcnt(0)" ::: "memory"); __builtin_amdgcn_sched_barrier(0);
        f32x16 Nn, Tt;
#pragma unroll
        for (int i = 0; i < 16; ++i) { const int sr = (i & 3) + 8 * (i >> 2) + 4 * h; const bool st = sr < c32, inc = sr <= c32;
            Nn[i] = st ? -Zba[i] : 0.f; Tt[i] = Nn[i] + (sr == c32 ? 1.f : 0.f); X[sr * 36 + c32] = Nn[i];
            Zka[i] = st ? Zka[i] : 0.f; Zbr[i] = inc ? Zbr[i] : 0.f; Zkr[i] = inc ? Zkr[i] : 0.f; }
        ST_FRAG(FR_LK + 0, acc_frag(Zka, 0)); ST_FRAG(FR_LK + 1, acc_frag(Zka, 1));
        ST_FRAG(FR_MB + 0, acc_frag(Zbr, 0)); ST_FRAG(FR_MB + 1, acc_frag(Zbr, 1));
        ST_FRAG(FR_MK + 0, acc_frag(Zkr, 0)); ST_FRAG(FR_MK + 1, acc_frag(Zkr, 1));
#define ROWFRAG(ks) ({ const f32x4 lo_ = *(const LAS f32x4*)(X + c32 * 36 + 16 * (ks) + 4 * h), hi_ = *(const LAS f32x4*)(X + c32 * 36 + 16 * (ks) + 8 + 4 * h); pack8v(lo_[0], lo_[1], lo_[2], lo_[3], hi_[0], hi_[1], hi_[2], hi_[3]); })
        asm volatile("s_waitcnt lgkmcnt(0)" ::: "memory");
        bf16x8 A0 = ROWFRAG(0), A1 = ROWFRAG(1);
#pragma unroll
        for (int lvl = 0; lvl < 4; ++lvl) {
            f32x16 Pn = {};
            Pn = __builtin_amdgcn_mfma_f32_32x32x16_bf16(A0, acc_frag(Nn, 0), Pn, 0, 0, 0); Pn = __builtin_amdgcn_mfma_f32_32x32x16_bf16(A1, acc_frag(Nn, 1), Pn, 0, 0, 0);
#pragma unroll
            for (int i = 0; i < 16; ++i) X[((i & 3) + 8 * (i >> 2) + 4 * h) * 36 + c32] = Pn[i];
            asm volatile("s_waitcnt lgkmcnt(0)" ::: "memory");
            A0 = ROWFRAG(0); A1 = ROWFRAG(1);
            const bf16x8 B0 = acc_frag(Tt, 0), B1 = acc_frag(Tt, 1);
            Tt = __builtin_amdgcn_mfma_f32_32x32x16_bf16(A0, B0, Tt, 0, 0, 0); Tt = __builtin_amdgcn_mfma_f32_32x32x16_bf16(A1, B1, Tt, 0, 0, 0);
            Nn = Pn; }
#undef ROWFRAG
#pragma unroll
        for (int i = 0; i < 16; ++i) Tt[i] = -Tt[i];
        ST_FRAG(FR_TI + 0, acc_frag(Tt, 0)); ST_FRAG(FR_TI + 1, acc_frag(Tt, 1));
        asm volatile("s_waitcnt lgkmcnt(0)" ::: "memory");
#undef UP4
#undef ST_FRAG
    }
}
__device__ __forceinline__ bool scan_wait_ge(volatile LAS unsigned* p, unsigned v) {
    for (unsigned sp = 0; (int)(*p - v) < 0; ++sp) { __builtin_amdgcn_s_sleep(0); if (sp > (1u << 24)) return false; }
    return true;
}
template <int dir>
__device__ __forceinline__ void phase_scan_pair(Frame& F, int sw, int itl, unsigned epoch) {
    unsigned char* act = F.ws + WS_ACT;
    const int hh = (sw >> 1) & 15, b = sw >> 5;
    const int lane = F.lane, c32 = lane & 31, h = lane >> 5;
    unsigned char* Ys = (unsigned char*)((bf16_t*)(act + A_Y) + (size_t)dir * M * RD + (size_t)b * SEQ * RD + hh * HD + 32 * itl);
    LAS float* YB = (LAS float*)(F.lds + SCAN_NSLOT * SCAN_LSLOT) + itl * (32 * 36);
    const unsigned yo = (unsigned)((dir ? 7 - (lane >> 3) : (lane >> 3)) * RD * 2 + (lane & 7) * 8);
    const LAS float* ybr = YB + (lane >> 3) * 36 + (lane & 7) * 4;
    LAS float* ybw = YB + (4 * h) * 36 + c32;
    LAS unsigned char* lds = F.lds;
    volatile LAS unsigned* landed = (volatile LAS unsigned*)(F.lds + MISC_OFF) + 16; volatile LAS unsigned* done = landed + 2;
#define MF(a_, b_, c_) __builtin_amdgcn_mfma_f32_32x32x16_bf16(a_, b_, c_, 0, 0, 0)
    f32x16 S0 = {}, S1 = {};
    __builtin_amdgcn_s_setprio(3);
    for (int c = 0; c < NCHUNK; ++c) {
        scan_wait_ge(landed, epoch + (unsigned)c + 1u);
        asm volatile("" ::: "memory");
        f32x4 yq[4];
#pragma unroll
        for (int k = 0; k < 4; ++k) yq[k] = *(const LAS f32x4*)(ybr + 8 * k * 36);
        const LAS unsigned char* sl = lds + (c & (SCAN_NSLOT - 1)) * SCAN_LSLOT + lane * 16;
#define LF(idx) (*(const LAS bf16x8*)(sl + (idx) * 1024))
        const bf16x8 v0 = LF(FR_VF + 2 * itl), lk0 = LF(FR_LK + 0), v1 = LF(FR_VF + 2 * itl + 1), lk1 = LF(FR_LK + 1);
        const bf16x8 at0 = LF(FR_AT + 0), at1 = LF(FR_AT + 1), at2 = LF(FR_AT + 2), at3 = LF(FR_AT + 3);
        const bf16x8 rt0 = LF(FR_RT + 0), rt1 = LF(FR_RT + 1), rt2 = LF(FR_RT + 2), rt3 = LF(FR_RT + 3), ti0 = LF(FR_TI + 0), ti1 = LF(FR_TI + 1);
        __builtin_amdgcn_sched_barrier(0);
        const bf16x8 a0 = acc_frag(S0, 0), a1 = acc_frag(S0, 1), a2 = acc_frag(S1, 0), a3 = acc_frag(S1, 1);
        f32x16 X = {};
        X = MF(lk0, v0, X); X = MF(lk1, v1, X);
        X = MF(at0, a0, X); X = MF(at1, a1, X); X = MF(at2, a2, X); X = MF(at3, a3, X);
        if (c > 0) { const unsigned vo = yo + (unsigned)(dir ? SEQ - SCT - (c - 1) * SCT : (c - 1) * SCT) * (unsigned)(RD * 2);
#pragma unroll
            for (int k = 0; k < 4; ++k) *(u32x2*)(Ys + (size_t)(vo + (unsigned)((dir ? 3 - k : k) * 8 * RD * 2))) = (u32x2){cvt_pk_bf16(yq[k][0], yq[k][1]), cvt_pk_bf16(yq[k][2], yq[k][3])}; }
        f32x4 cta[4], ctb[4];
        { const LAS float* ct = (const LAS float*)(lds + (c & (SCAN_NSLOT - 1)) * SCAN_LSLOT + 28 * 1024) + 4 * h;
#pragma unroll
          for (int g = 0; g < 4; ++g) { cta[g] = *(const LAS f32x4*)(ct + 8 * g); ctb[g] = *(const LAS f32x4*)(ct + 32 + 8 * g); } }
        const bf16x8 kp0 = LF(FR_KP + 0), kp2 = LF(FR_KP + 2), kp1 = LF(FR_KP + 1), kp3 = LF(FR_KP + 3);
        __builtin_amdgcn_sched_barrier(0);
        f32x16 Yt = {};
        Yt = MF(rt0, a0, Yt); Yt = MF(rt1, a1, Yt); Yt = MF(rt2, a2, Yt); Yt = MF(rt3, a3, Yt);
        const bf16x8 mk0 = LF(FR_MK + 0), mk1 = LF(FR_MK + 1), bp0 = LF(FR_BP + 0), bp2 = LF(FR_BP + 2), bp1 = LF(FR_BP + 1), bp3 = LF(FR_BP + 3), mb0 = LF(FR_MB + 0), mb1 = LF(FR_MB + 1);
        asm volatile("" ::: "memory");
        done[itl] = epoch + (unsigned)c + 1u;
        __builtin_amdgcn_sched_barrier(0);
        const bf16x8 x0 = acc_frag(X, 0), x1 = acc_frag(X, 1);
        f32x16 U = {};
        U = MF(ti0, x0, U); U = MF(ti1, x1, U);
#pragma unroll
        for (int g = 0; g < 4; ++g)
#pragma unroll
            for (int e = 0; e < 4; ++e) { S0[4 * g + e] *= cta[g][e]; S1[4 * g + e] *= ctb[g][e]; }
        S0 = MF(kp0, v0, S0); S1 = MF(kp2, v0, S1); S0 = MF(kp1, v1, S0); S1 = MF(kp3, v1, S1);
        Yt = MF(mk0, v0, Yt); Yt = MF(mk1, v1, Yt);
        const bf16x8 u0 = acc_frag(U, 0), u1 = acc_frag(U, 1);
        S0 = MF(bp0, u0, S0); S1 = MF(bp2, u0, S1); S0 = MF(bp1, u1, S0); S1 = MF(bp3, u1, S1);
        Yt = MF(mb0, u0, Yt); Yt = MF(mb1, u1, Yt);
#pragma unroll
        for (int i = 0; i < 16; ++i) ybw[((i & 3) + 8 * (i >> 2)) * 36] = Yt[i];
#undef LF
    }
    { const unsigned vo = yo + (unsigned)(dir ? SEQ - SCT - (NCHUNK - 1) * SCT : (NCHUNK - 1) * SCT) * (unsigned)(RD * 2);
#pragma unroll
      for (int k = 0; k < 4; ++k) { const f32x4 q4 = *(const LAS f32x4*)(ybr + 8 * k * 36); *(u32x2*)(Ys + (size_t)(vo + (unsigned)((dir ? 3 - k : k) * 8 * RD * 2))) = (u32x2){cvt_pk_bf16(q4[0], q4[1]), cvt_pk_bf16(q4[2], q4[3])}; } }
    __builtin_amdgcn_s_setprio(0);
#undef MF
}
__device__ __forceinline__ void phase_scan_loader(Frame& F, int sw, unsigned epoch) {
    const int dir = sw & 1, hh = (sw >> 1) & 15, b = sw >> 5, lane = F.lane;
    const unsigned char* frs = F.ws + WS_ACT + A_FR + (size_t)(((b * RH + hh) * 2 + dir) * NCHUNK) * FR_STRIDE; const unsigned fro = (unsigned)lane * 16u;
    LAS unsigned char* lds = F.lds;
    volatile LAS unsigned* landed = (volatile LAS unsigned*)(F.lds + MISC_OFF) + 16; volatile LAS unsigned* done = landed + 2;
    for (int c = 0; c < NCHUNK; ++c) {
        if (c >= SCAN_NSLOT) { scan_wait_ge(&done[0], epoch + (unsigned)(c - SCAN_NSLOT + 1)); scan_wait_ge(&done[1], epoch + (unsigned)(c - SCAN_NSLOT + 1)); }
        asm volatile("" ::: "memory");
        const unsigned char* src = frs + (size_t)c * FR_STRIDE; LAS unsigned char* dst = lds + (c & (SCAN_NSLOT - 1)) * SCAN_LSLOT;
#pragma unroll 4
        for (int f = 0; f < 28; ++f) __builtin_amdgcn_global_load_lds((const unsigned*)(src + f * 1024 + fro), (LAS unsigned*)(dst + f * 1024), 16, 0, 2);
        __builtin_amdgcn_global_load_lds((const unsigned*)(src + 28 * 1024 + (unsigned)lane * 4u), (LAS unsigned*)(dst + 28 * 1024), 4, 0, 2);
        if (c >= 2) { asm volatile("s_waitcnt vmcnt(58)" ::: "memory"); landed[0] = epoch + (unsigned)(c - 1); }
    }
    asm volatile("s_waitcnt vmcnt(29)" ::: "memory"); landed[0] = epoch + (unsigned)(NCHUNK - 1);
    asm volatile("s_waitcnt vmcnt(0)" ::: "memory"); landed[0] = epoch + (unsigned)NCHUNK;
}

__device__ __forceinline__ void phase_post(const Args& AR, Frame& F, int l) {
    const bf16_t* V = (const bf16_t*)(F.ws + WS_ACT + A_V); const bf16_t* G = (const bf16_t*)(F.ws + WS_ACT + A_G);
    const float* BS0 = (const float*)(F.ws + WS_ACT + A_BS); const float* BS1 = BS0 + (size_t)M * RH;
    const bf16_t* Y0 = (const bf16_t*)(F.ws + WS_ACT + A_Y); const bf16_t* Y1 = Y0 + (size_t)M * RD;
    const bf16_t* OG = (const bf16_t*)(F.ws + WS_ACT + A_OG); const float* LSE = (const float*)(F.ws + WS_ACT + A_LSE);
    bf16_t* OC = (bf16_t*)(F.ws + WS_ACT + A_OCAT);
    const float* gn_w = AR.in[12] + (size_t)l * RD; const float* gn_b = AR.in[13] + (size_t)l * RD;
    { u64* ssqA = (u64*)(F.ws + WS_SSQA); u64* ssqB = (u64*)(F.ws + WS_SSQB);
      for (int i = F.bx * NTHREADS + F.tid; i < M; i += F.G * NTHREADS) { ssqA[i] = 0ull; ssqB[i] = 0ull; } }
    f32x4 gwv[2][2], gbv[2][2];
#pragma unroll
    for (int j = 0; j < 2; ++j) { const int cc = (F.lane + 64 * j) * 8; gwv[j][0] = *(const f32x4*)(gn_w + cc); gwv[j][1] = *(const f32x4*)(gn_w + cc + 4); gbv[j][0] = *(const f32x4*)(gn_b + cc); gbv[j][1] = *(const f32x4*)(gn_b + cc + 4); }
    for (int m = F.gw; m < M; m += F.NGW) {
        u32x4 ya[2], yb[2], vw[2], gw_[2], og[3]; float bsv[2], lse[3];
#pragma unroll
        for (int j = 0; j < 2; ++j) { const int cc = (F.lane + 64 * j) * 8; const size_t off = (size_t)m * RD + cc;
            ya[j] = *(const u32x4*)(Y0 + off); yb[j] = *(const u32x4*)(Y1 + off); vw[j] = *(const u32x4*)(V + off); gw_[j] = *(const u32x4*)(G + off);
            bsv[j] = BS0[(size_t)m * RH + (cc >> 6)] + BS1[(size_t)m * RH + (cc >> 6)]; }
#pragma unroll
        for (int g = 0; g < 3; ++g) { og[g] = *(const u32x4*)(OG + ((size_t)g * M + m) * AOD + F.lane * 8); lse[g] = LSE[((size_t)g * M + m) * 8 + (F.lane >> 3)]; }
        __builtin_amdgcn_sched_barrier(0);
#pragma unroll
        for (int j = 0; j < 2; ++j) { const int cc = (F.lane + 64 * j) * 8;
            float y[8], vv[8], gg[8];
            unpack8(ya[j], y); { float t[8]; unpack8(yb[j], t);
#pragma unroll
                for (int e = 0; e < 8; ++e) y[e] += t[e]; }
            unpack8(vw[j], vv); unpack8(gw_[j], gg);
            const float bs = bsv[j];
            float s = 0.f;
#pragma unroll
            for (int e = 0; e < 8; ++e) s += y[e];
            s += __shfl_xor(s, 1); s += __shfl_xor(s, 2); s += __shfl_xor(s, 4);
            const float mean = s * (1.0f / 64.0f); float q = 0.f;
#pragma unroll
            for (int e = 0; e < 8; ++e) { y[e] -= mean; q += y[e] * y[e]; }
            q += __shfl_xor(q, 1); q += __shfl_xor(q, 2); q += __shfl_xor(q, 4);
            const float rstd = __builtin_amdgcn_rsqf(q * (1.0f / 64.0f) + GN_EPS); float o[8];
#pragma unroll
            for (int e = 0; e < 8; ++e) o[e] = (y[e] * rstd * gwv[j][e >> 2][e & 3] + gbv[j][e >> 2][e & 3] + bs * vv[e]) * gg[e];
            *(u32x4*)(OC + (size_t)m * OCAT + cc) = pack8(o); }
        { const int cc = F.lane * 8;
            const float l0 = lse[0], l1 = lse[1], l2 = lse[2];
            const float mx = fmaxf(l0, fmaxf(l1, l2)); float w0 = __expf(l0 - mx), w1 = __expf(l1 - mx), w2 = __expf(l2 - mx); const float inv = 1.0f / (w0 + w1 + w2); w0 *= inv; w1 *= inv; w2 *= inv;
            float a[8], t[8], o[8]; unpack8(og[0], a);
#pragma unroll
            for (int e = 0; e < 8; ++e) o[e] = w0 * a[e];
            unpack8(og[1], t);
#pragma unroll
            for (int e = 0; e < 8; ++e) o[e] += w1 * t[e];
            unpack8(og[2], t);
#pragma unroll
            for (int e = 0; e < 8; ++e) o[e] += w2 * t[e];
            *(u32x4*)(OC + (size_t)m * OCAT + RD + cc) = pack8(o); }
    }
}

__device__ __forceinline__ void phase_final(const Args& AR, Frame& F, float* out) {
    const float* fg = AR.in[21];
    const bf16_t* HBp = (const bf16_t*)(F.ws + WS_ACT + A_HB);
    f32x4 fgv[4][2];
#pragma unroll
    for (int j = 0; j < 4; ++j) { const int c = (F.lane + 64 * j) * 8; fgv[j][0] = *(const f32x4*)(fg + c); fgv[j][1] = *(const f32x4*)(fg + c + 4); }
    for (int m = F.gw; m < M; m += F.NGW) {
        float v[4][8]; float s = 0.f;
#pragma unroll
        for (int j = 0; j < 4; ++j) { unpack8(*(const u32x4*)(HBp + (size_t)m * DM + (F.lane + 64 * j) * 8), v[j]);
#pragma unroll
            for (int e = 0; e < 8; ++e) s += v[j][e] * v[j][e]; }
        const float rs = __builtin_amdgcn_rsqf(wave_sum(s) * (1.0f / DM) + RMS_EPS);
#pragma unroll
        for (int j = 0; j < 4; ++j) { const int c = (F.lane + 64 * j) * 8; const f32x4 g0 = fgv[j][0], g1 = fgv[j][1];
            *(f32x4*)(out + (size_t)m * DM + c) = (f32x4){v[j][0] * rs * g0[0], v[j][1] * rs * g0[1], v[j][2] * rs * g0[2], v[j][3] * rs * g0[3]};
            *(f32x4*)(out + (size_t)m * DM + c + 4) = (f32x4){v[j][4] * rs * g1[0], v[j][5] * rs * g1[1], v[j][6] * rs * g1[2], v[j][7] * rs * g1[3]}; }
    }
}

constexpr int PH_PER_LAYER = 10, N_PHASES = 2 + DEPTH * PH_PER_LAYER;
__global__ void __launch_bounds__(NTHREADS, 2) fwd_kernel(Args args) {
    __shared__ __attribute__((aligned(16))) unsigned char lds_raw[LDS_BYTES];
    Frame F;
    F.lds = (LAS unsigned char*)lds_raw; F.tid = threadIdx.x; F.lane = F.tid & 63; F.wave = __builtin_amdgcn_readfirstlane(F.tid >> 6);
    F.G = gridDim.x; F.gw = blockIdx.x * NWAVES + F.wave; F.NGW = F.G * NWAVES; F.ws = args.ws;
    volatile LAS unsigned* MISC = (volatile LAS unsigned*)(F.lds + MISC_OFF);
    if (F.tid < 64) MISC[F.tid] = 0u;
    __syncthreads();
    XcdBarrier bar = xcd_barrier_post(g_bar, MISC + 8);
    const int lo = args.ph_lo, hi = args.ph_hi;
    int ph = 0;
#define PHASE_BEGIN if (ph >= lo && ph < hi) { F.ws = launder(F.ws); asm volatile("" : "+v"(F.tid)); F.lane = F.tid & 63; { int bx = blockIdx.x, wv = F.wave; asm volatile("" : "+s"(bx), "+s"(wv)); F.bx = bx; F.wave = wv; F.gw = bx * NWAVES + wv; F.lds = (LAS unsigned char*)lds_raw; } unsigned char* act = F.ws + WS_ACT; unsigned char* wl = F.ws + WS_W + (size_t)l * W_LAYER_B;
#define PHASE_END   if (ph + 1 < hi) xcd_barrier(bar); } ++ph;

    int l = 0;
    PHASE_BEGIN (void)act; (void)wl; p0_prologue(args, F);
    PHASE_END

#pragma unroll 1
    for (l = 0; l < DEPTH; ++l) {
        PHASE_BEGIN {
            pg8::Gemm g{(const bf16_t*)(act + A_HB), (const bf16_t*)(wl + WO_IN), DM, DM}; pg8::PlainSched S; S.init(M, NINP - 256, F.G, F.bx); S.nt = DM / 64;
            pg8::EpiProj E{(bf16_t*)(act + A_PROJ), (const u64*)(F.ws + WS_SSQA)};
            pg8::gemm_phase<pg8::EpiProj, pg8::PlainSched, true>(F.lds, F.tid, g, S, E);
        } PHASE_END
        PHASE_BEGIN phase_shift(args, F, l);
        PHASE_END
        PHASE_BEGIN {
            constexpr int NTAIL = M / 256;
            if (F.G > 2 * NTAIL && F.bx < NTAIL) {
                pg8::Gemm g{(const bf16_t*)(act + A_HB), (const bf16_t*)(wl + WO_IN), DM, DM}; pg8::ProjTailSched S; S.c = F.bx; { int ntv = DM / 64; asm volatile("" : "+s"(ntv)); S.nt = ntv; }
                pg8::EpiProj E{(bf16_t*)(act + A_PROJ), (const u64*)(F.ws + WS_SSQA)};
                pg8::gemm_phase<pg8::EpiProj, pg8::ProjTailSched, false>(F.lds, F.tid, g, S, E);
            } else {
                const bool split = F.G > 2 * NTAIL;
                pg8::Gemm g{(const bf16_t*)(act + A_LIN), (const bf16_t*)(wl + WO_LORA), LORA_K, LORA_K}; pg8::LoraSched S; S.init(M, LORA_N, split ? F.G - NTAIL : F.G, split ? F.bx - NTAIL : F.bx); { int ntv = 4; asm volatile("" : "+s"(ntv)); S.nt = ntv; }
                pg8::EpiLora E{act, args.in[4] + (size_t)l * 2 * RD, args.in[6] + (size_t)l * 2 * RD};
                pg8::gemm_phase<pg8::EpiLora, pg8::LoraSched, true>(F.lds, F.tid, g, S, E);
                if (split) {
                    const int wi = (F.bx - NTAIL) * NWAVES + F.wave, nw = (F.G - NTAIL) * NWAVES; LAS float* scr = (LAS float*)(F.lds + F.wave * 16384);
                    convert_weights(args, F.ws, l, 2, wi, nw, scr, F.lane, 0, 3);
                    if (l + 1 < DEPTH) convert_weights(args, F.ws, l + 1, 1, wi, nw, scr, F.lane, 0, 3); }
            }
        } PHASE_END
        PHASE_BEGIN phase_scan_prep(F, args.in[10] + (size_t)l * RD, args.in[11] + (size_t)l * RD);
        PHASE_END
        PHASE_BEGIN {
            const int nsb = BATCH * RH * 2;
            if (F.bx < nsb && F.wave < 2) { if (F.bx & 1) phase_scan_pair<1>(F, F.bx, F.wave, (unsigned)l * 256u); else phase_scan_pair<0>(F, F.bx, F.wave, (unsigned)l * 256u); }
            else if (F.bx < nsb && F.wave == 2) phase_scan_loader(F, F.bx, (unsigned)l * 256u);
            else if (F.bx >= nsb || SCAN_WG_WORKER(F.wave) >= 0) {
                const int aw0 = F.bx < nsb ? F.bx * SCAN_NSW + SCAN_WG_WORKER(F.wave) : nsb * SCAN_NSW + (F.bx - nsb) * NWAVES + F.wave, naw = nsb * SCAN_NSW + (F.G - nsb) * NWAVES;
                const int ntask = BATCH * AH * 128, n4 = ntask % naw, aw = (aw0 + naw - nsb * SCAN_NSW) % naw;
                const bool four = aw < n4; const int wcount = four ? 4 : 5, vwi = four ? (naw - n4) * 5 + aw * 4 : (aw - n4) * 5, vnw = (naw - n4) * 5 + n4 * 4;
                const bool attn_first = (F.wave & 1) != 0;
                if (attn_first) phase_attn(F, aw, naw);
                LAS float* scr = (LAS float*)(F.lds + 2 * FR_STRIDE + F.wave * 8448);
                const int cq0 = F.G > 64 ? 3 : 0;
                convert_weights(args, F.ws, l, 2, vwi, vnw, scr, F.lane, cq0, 8, wcount, aw, naw);
                if (l + 1 < DEPTH) convert_weights(args, F.ws, l + 1, 1, vwi, vnw, scr, F.lane, cq0, 8, wcount, aw, naw);
                if (!attn_first) phase_attn(F, aw, naw);
            }
        } PHASE_END

        PHASE_BEGIN phase_post(args, F, l);
        PHASE_END
        PHASE_BEGIN {
            pg8::Gemm g{(const bf16_t*)(act + A_OCAT), (const bf16_t*)(wl + WO_BR), OCAT, OCAT}; pg8::BranchSched S; S.init(M, DM, F.G, F.bx); { int ntv = AOD / 64; asm volatile("" : "+s"(ntv)); S.nt0 = ntv; }
            pg8::EpiBranch E{(bf16_t*)(act + A_Y), (const bf16_t*)(act + A_PROJ)};
            pg8::gemm_phase<pg8::EpiBranch, pg8::BranchSched, true>(F.lds, F.tid, g, S, E);
        } PHASE_END
        PHASE_BEGIN {
            pg8::Gemm g{(const bf16_t*)(act + A_Y), (const bf16_t*)(wl + WO_OUT), DM, DM}; pg8::PlainSched S; S.init(M, DM, F.G, F.bx); S.nt = DM / 64;
            if (l == 0) { pg8::EpiResid<true> E{(const void*)args.in[0], (bf16_t*)(act + A_HB), (u64*)(F.ws + WS_SSQB)}; pg8::gemm_phase<pg8::EpiResid<true>, pg8::PlainSched, true>(F.lds, F.tid, g, S, E); }
            else { pg8::EpiResid<false> E{(const void*)(act + A_HB), (bf16_t*)(act + A_HB), (u64*)(F.ws + WS_SSQB)}; pg8::gemm_phase<pg8::EpiResid<false>, pg8::PlainSched, true>(F.lds, F.tid, g, S, E); }
        } PHASE_END
        PHASE_BEGIN {
            pg8::Gemm g{(const bf16_t*)(act + A_HB), (const bf16_t*)(wl + WO_MI), DM, DM}; pg8::PlainSched S; S.init(M, DFF, F.G, F.bx); S.nt = DM / 64;
            pg8::EpiMlpIn E{(bf16_t*)(act + A_PROJ), (const u64*)(F.ws + WS_SSQB)};
            pg8::gemm_phase<pg8::EpiMlpIn, pg8::PlainSched, true>(F.lds, F.tid, g, S, E);
        } PHASE_END
        PHASE_BEGIN {
            pg8::Gemm g{(const bf16_t*)(act + A_PROJ), (const bf16_t*)(wl + WO_MO), DFF, DFF}; pg8::PlainSched S; S.init(M, DM, F.G, F.bx); S.nt = DFF / 64;
            pg8::EpiResid<false> E{(const void*)(act + A_HB), (bf16_t*)(act + A_HB), (u64*)(F.ws + WS_SSQA)};
            pg8::gemm_phase<pg8::EpiResid<false>, pg8::PlainSched, true>(F.lds, F.tid, g, S, E);
        } PHASE_END
    }
    PHASE_BEGIN (void)act; (void)wl; phase_final(args, F, args.out); PHASE_END
#undef PHASE_BEGIN
#undef PHASE_END
    __syncthreads();
    if (F.tid == 0) {
        const unsigned old = xb_add(&g_bar[XB_EXIT], 1u);
        if (old + 1u == gridDim.x) {
            __hip_atomic_store(&g_bar[XB_TMO], 0u, __ATOMIC_RELAXED, __HIP_MEMORY_SCOPE_AGENT);
            for (int j = 0; j < 16; ++j) { __hip_atomic_store(&g_bar[XB_XCNT(j)], 0u, __ATOMIC_RELAXED, __HIP_MEMORY_SCOPE_AGENT); __hip_atomic_store(&g_bar[XB_XSUB(j)], 0u, __ATOMIC_RELAXED, __HIP_MEMORY_SCOPE_AGENT); __hip_atomic_store(&g_bar[XB_XGEN(j)], 0u, __ATOMIC_RELAXED, __HIP_MEMORY_SCOPE_AGENT); }
            __hip_atomic_store(&g_bar[XB_TOP], 0u, __ATOMIC_RELAXED, __HIP_MEMORY_SCOPE_AGENT); __hip_atomic_store(&g_bar[XB_TOPGEN], 0u, __ATOMIC_RELAXED, __HIP_MEMORY_SCOPE_AGENT);
            __hip_atomic_store(&g_bar[XB_EXIT], 0u, __ATOMIC_RELAXED, __HIP_MEMORY_SCOPE_AGENT);
        }
    }
}

extern "C" void kernel_launch(void* const* d_in, const int* in_sizes, int n_in, void* d_out, int out_size, void* d_ws, size_t ws_size, hipStream_t stream) {
    static int grid = 0;
    if (grid == 0) {
        if (n_in != 22 || out_size != M * DM || ws_size < WS_END) { fprintf(stderr, "kernel_launch: unexpected shapes (n_in %d, out %d, ws %zu < %zu)\n", n_in, out_size, ws_size, (size_t)WS_END); grid = -1; return; }
        int dev = 0, cus = 0, per_cu = 0;
        if (hipGetDevice(&dev) != hipSuccess || hipDeviceGetAttribute(&cus, hipDeviceAttributeMultiprocessorCount, dev) != hipSuccess) { grid = -1; return; }
        if (hipOccupancyMaxActiveBlocksPerMultiprocessor(&per_cu, (const void*)fwd_kernel, NTHREADS, 0) != hipSuccess || per_cu < 1) fprintf(stderr, "kernel_launch: occupancy query says %d\n", per_cu);
        (void)hipGetLastError();
        grid = cus;
    }
    if (grid < 0) return;
    Args a{};
    for (int i = 0; i < 22; ++i) a.in[i] = (const float*)d_in[i];
    a.out = (float*)d_out; a.ws = (unsigned char*)d_ws;
    a.ph_lo = 0; a.ph_hi = N_PHASES;
    hipLaunchKernelGGL(fwd_kernel, dim3(grid), dim3(NTHREADS), 0, stream, a);
}
```

```cpp
#include <hip/hip_runtime.h>
#include <cstdio>
#include <cstdint>

#define GAS __attribute__((address_space(1)))
#define LAS __attribute__((address_space(3)))
typedef unsigned short bf16_t;
typedef short bf16x8 __attribute__((ext_vector_type(8)));
typedef float f32x2 __attribute__((ext_vector_type(2)));
typedef float f32x4 __attribute__((ext_vector_type(4)));
typedef float f32x16 __attribute__((ext_vector_type(16)));
typedef unsigned u32x2 __attribute__((ext_vector_type(2)));
typedef unsigned u32x4 __attribute__((ext_vector_type(4)));

constexpr int DM = 2048, BATCH = 2, SEQ = 4096, DEPTH = 4, M = BATCH * SEQ;
constexpr int HD = 64, RH = 16, RD = 1024;
constexpr int RWKV_COLS = 3712, SLABP = 3840;
constexpr int AH = 24, AD = 1536, AOD = 512;
constexpr int NIN = 12416, NINP = 12544;
constexpr int QOFF = SLABP, KOFF = SLABP + AD, VOFF = SLABP + 2 * AD, GOFF = SLABP + 3 * AD;
constexpr int DFF = 8192;
constexpr int LORA_K = 768, LORA_N = 5120;
constexpr int OCAT = 1536;
constexpr float RMS_EPS = 1e-6f, GN_EPS = 64e-5f;
constexpr int NWAVES = 8, NTHREADS = 512;

constexpr size_t MiB = 1u << 20;
constexpr size_t WS_CTL = 0, CTL_ZERO_BYTES = 1 * MiB;
constexpr size_t WS_BTAB = 1 * MiB;
constexpr size_t WS_SSQA = WS_BTAB + 64 * 1024, WS_SSQB = WS_SSQA + 64 * 1024;
constexpr size_t WS_W = 2 * MiB;
constexpr size_t W_IN_B = (size_t)NINP * DM * 2, W_BR_B = (size_t)DM * OCAT * 2, W_OUT_B = (size_t)DM * DM * 2, W_MI_B = (size_t)DFF * DM * 2, W_MO_B = (size_t)DM * DFF * 2, W_LORA_B = (size_t)LORA_N * LORA_K * 2;
constexpr size_t WO_IN = 0, WO_BR = WO_IN + W_IN_B, WO_OUT = WO_BR + W_BR_B, WO_MI = WO_OUT + W_OUT_B, WO_MO = WO_MI + W_MI_B, WO_LORA = WO_MO + W_MO_B, W_LAYER_B = WO_LORA + W_LORA_B;
constexpr size_t WS_ACT = WS_W + DEPTH * W_LAYER_B;
constexpr size_t A_HB = 0;
constexpr size_t A_H = A_HB + (size_t)M * DM * 2;
constexpr size_t A_BS = A_H;
constexpr size_t A_PROJ = A_H + (size_t)M * DM * 4;
constexpr size_t A_R = A_PROJ + (size_t)M * NINP * 2;
constexpr size_t F32RD = (size_t)M * RD * 4;
constexpr size_t A_K = A_R + F32RD, A_V = A_K + F32RD, A_KK = A_V + F32RD, A_WF = A_KK + F32RD, A_WB = A_WF + F32RD, A_AF = A_WB + F32RD, A_AB = A_AF + F32RD, A_G = A_AB + F32RD;
constexpr size_t A_Y = A_G + F32RD;
constexpr size_t A_OG = A_Y + 2 * F32RD;
constexpr size_t A_LSE = A_OG + (size_t)3 * M * AOD * 4;
constexpr size_t A_VT = A_LSE + (size_t)3 * M * 8 * 4;
constexpr size_t A_LIN = A_VT + (size_t)BATCH * AH * HD * SEQ * 2;
constexpr size_t A_OCAT = A_LIN + (size_t)M * LORA_K * 2;
constexpr int SCT = 32, NCHUNK = SEQ / SCT;
constexpr int FR_STRIDE = 29 * 1024;
constexpr int FR_AT = 0, FR_RT = 4, FR_LK = 8, FR_TI = 10, FR_MB = 12, FR_MK = 14, FR_BP = 16, FR_KP = 20, FR_VF = 24, FR_CT_BYTE = 28 * 1024;
constexpr size_t A_FR = A_LIN;
constexpr size_t FR_BYTES = (size_t)BATCH * RH * 2 * NCHUNK * FR_STRIDE;
constexpr size_t A_END = (A_OCAT + (size_t)M * OCAT * 2) > (A_FR + FR_BYTES) ? (A_OCAT + (size_t)M * OCAT * 2) : (A_FR + FR_BYTES);
constexpr size_t WS_END = WS_ACT + A_END;
static_assert((size_t)M * DFF * 2 <= (size_t)M * NINP * 2, "HID overlays PROJ");

constexpr int RING_BYTES = 141440;
constexpr int MISC_OFF = RING_BYTES;
constexpr int SCAN_NSLOT = 4;
constexpr int SCAN_LSLOT = 28 * 1024 + 256;
constexpr int SCAN_NSW = 0;
#define SCAN_WG_WORKER(w) (SCAN_NSW == 6 ? (w) - 2 : (SCAN_NSW == 4 ? ((w) == 2 || (w) == 3 ? (w) - 2 : ((w) >= 6 ? (w) - 4 : -1)) : -1))
constexpr int PARAM_OFF = RING_BYTES + 256;
constexpr int LDS_BYTES = PARAM_OFF + NWAVES * 512;

typedef __bf16 bf16x2_t __attribute__((ext_vector_type(2)));
__device__ __forceinline__ unsigned cvt_pk_bf16(float lo, float hi) { f32x2 v = {lo, hi}; bf16x2_t b = __builtin_convertvector(v, bf16x2_t); return __builtin_bit_cast(unsigned, b); }
__device__ __forceinline__ float bf_lo(unsigned u) { return __uint_as_float(u << 16); }
__device__ __forceinline__ float bf_hi(unsigned u) { return __uint_as_float(u & 0xffff0000u); }
__device__ __forceinline__ float bf1(bf16_t u) { return __uint_as_float(((unsigned)u) << 16); }
__device__ __forceinline__ float sigmoidf_(float x) { return __builtin_amdgcn_rcpf(1.0f + __expf(-x)); }
__device__ __forceinline__ void unpack8(const u32x4 w, float (&f)[8]) { f[0] = bf_lo(w.x); f[1] = bf_hi(w.x); f[2] = bf_lo(w.y); f[3] = bf_hi(w.y); f[4] = bf_lo(w.z); f[5] = bf_hi(w.z); f[6] = bf_lo(w.w); f[7] = bf_hi(w.w); }
__device__ __forceinline__ u32x4 pack8(const float (&f)[8]) { u32x4 w; w.x = cvt_pk_bf16(f[0], f[1]); w.y = cvt_pk_bf16(f[2], f[3]); w.z = cvt_pk_bf16(f[4], f[5]); w.w = cvt_pk_bf16(f[6], f[7]); return w; }

__device__ __forceinline__ f32x4 ld4bf(const bf16_t* p) { const u32x2 w = *(const u32x2*)p; return (f32x4){bf_lo(w.x), bf_hi(w.x), bf_lo(w.y), bf_hi(w.y)}; }
typedef unsigned long long u64;
__device__ __forceinline__ void ssq_add(u64* p, float s) { atomicAdd(p, (u64)(s * 16777216.0f + 0.5f)); }
__device__ __forceinline__ float ssq_get(const u64* p) { return (float)(*p) * (1.0f / 16777216.0f); }
namespace pg8 {
constexpr int BM = 256, BK = 64, HALF = 128, HTB = HALF * BK * 2, STAGE_BYTES = 8 * HTB, NXCD = 8, WGM = 8;
__host__ __device__ __forceinline__ int lds_byte(int r, int c) { const int st = (r >> 4) * 2 + (c >> 5), rr = r & 15, cc = c & 31, ob = rr * 64 + cc * 2; return st * 1024 + (ob ^ (((ob >> 9) & 1) << 5)); }
__host__ __device__ __forceinline__ void stage_rc(int b, int& R, int& C) { const int st = b / 1024, sb = b % 1024, swz = sb ^ (((sb >> 9) & 1) << 5); R = (st >> 1) * 16 + swz / 64; C = (st & 1) * 32 + (swz % 64) / 2; }
__host__ __device__ __forceinline__ int perm32(int rho) { const int n = rho >> 4, i = rho & 15; return 8 * (i >> 2) + 4 * n + (i & 3); }

struct Unit { int pm, pn, koff, nt, tag; };
struct Gemm { const bf16_t* A; const bf16_t* Bt; int lda, ldb; };

struct StaticOrder {
    int nM, nN, nwg, G, c;
    __device__ void init(int M_, int N_, int G_, int c_) { nM = M_ / BM; nN = N_ / BM; nwg = nM * nN; G = G_; c = c_; }
    __device__ bool map(int i, int& pm, int& pn) const {
        const long L = (long)i * G + c; if (L >= nwg) return false;
        int wgid = (int)L; { const int q = nwg / NXCD, r = nwg % NXCD, xcd = wgid % NXCD, off = wgid / NXCD; wgid = (xcd < r ? xcd * (q + 1) : r * (q + 1) + (xcd - r) * q) + off; }
        const int nig = WGM * nN, gid = wgid / nig, fm = gid * WGM, gsz = (nM - fm) < WGM ? (nM - fm) : WGM;
        pm = fm + ((wgid % nig) % gsz); pn = (wgid % nig) / gsz; return true;
    }
};
struct PlainSched : StaticOrder {
    int nt;
    __device__ bool next(int i, Unit& u) const { if (!map(i, u.pm, u.pn)) return false; u.koff = 0; u.nt = nt; u.tag = 0; return true; }
};

template <class Epi, class Sched, bool ALIGN_EPI>
__device__ __forceinline__ void gemm_phase(LAS unsigned char* lds, const int tid, const Gemm g, const Sched& S, const Epi& E) {
    const int wid = __builtin_amdgcn_readfirstlane(tid >> 6), lane = tid & 63, wr = wid >> 2, wc = wid & 3, fr = lane & 15, fq = lane >> 4;
    const int lda = g.lda, ldb = g.ldb;
    unsigned voffA[2], voffB[2];
#pragma unroll
    for (int i = 0; i < 2; ++i) { int R, C; stage_rc(tid * 16 + i * 8192, R, C); const int Rb = Epi::PERM ? ((R & ~31) + perm32(R & 31)) : R;
        voffA[i] = (unsigned)(R * lda + C) * 2u; voffB[i] = (unsigned)(Rb * ldb + C) * 2u; }
    const size_t kstep = (size_t)(BK * 2);
    const size_t hstepA = (size_t)HALF * lda * 2, hstepB = (size_t)HALF * ldb * 2;
    const unsigned ldsw = (unsigned)wid * 1024u;
    const int aoff = lds_byte(wr * 64 + fr, fq * 8), boff = lds_byte(wc * 32 + fr, fq * 8);
#define PG8_SA(b, h) (((b) * 2 + (h)) * HTB)
#define PG8_SB(b, h) ((4 + (b) * 2 + (h)) * HTB)
#define PG8_STAGE(bufoff, gbase, voff) do { _Pragma("unroll") for (int _i = 0; _i < 2; ++_i) \
        __builtin_amdgcn_global_load_lds((const unsigned*)((const char*)(gbase) + (voff)[_i]), (LAS unsigned*)(lds + (bufoff) + ldsw + _i * 8192), 16, 0, 0); } while (0)
#define PG8_LDA(dst, b, h) do { _Pragma("unroll") for (int m = 0; m < 4; ++m) _Pragma("unroll") for (int k = 0; k < 2; ++k) dst[m][k] = *(const LAS bf16x8*)(lds + PG8_SA(b, h) + aoff + m * 2048 + k * 1024); } while (0)
#define PG8_LDB(dst, b, h) do { _Pragma("unroll") for (int n = 0; n < 2; ++n) _Pragma("unroll") for (int k = 0; k < 2; ++k) dst[n][k] = *(const LAS bf16x8*)(lds + PG8_SB(b, h) + boff + n * 2048 + k * 1024); } while (0)
#define PG8_MMA(ai, bj, At, Bt) do { __builtin_amdgcn_s_setprio(1); _Pragma("unroll") for (int m = 0; m < 4; ++m) _Pragma("unroll") for (int n = 0; n < 2; ++n) _Pragma("unroll") for (int k = 0; k < 2; ++k) \
        acc[ai][bj][m][n] = __builtin_amdgcn_mfma_f32_16x16x32_bf16(Bt[n][k], At[m][k], acc[ai][bj][m][n], 0, 0, 0); __builtin_amdgcn_s_setprio(0); } while (0)
#define PG8_WAIT_V(n) asm volatile("s_waitcnt vmcnt(" #n ")" ::: "memory")
#define PG8_WAIT_L(n) asm volatile("s_waitcnt lgkmcnt(" #n ")" ::: "memory")
#define PG8_BAR __builtin_amdgcn_s_barrier()
#define PG8_SCHED __builtin_amdgcn_sched_barrier(0)
    Unit cur, nxt; int ui = 0;
    if (!S.next(0, cur)) return;
    f32x4 acc[2][2][4][2];
#pragma unroll
    for (int a = 0; a < 2; ++a)
#pragma unroll
        for (int b = 0; b < 2; ++b)
#pragma unroll
            for (int m = 0; m < 4; ++m)
#pragma unroll
                for (int n = 0; n < 2; ++n) acc[a][b][m][n] = (f32x4){0.f, 0.f, 0.f, 0.f};
    bf16x8 At[4][2], B0[2][2], B1[2][2];
    const char* cA = (const char*)g.A + ((size_t)cur.pm * BM * lda + cur.koff) * 2; const char* cB = (const char*)g.Bt + ((size_t)cur.pn * BM * ldb + cur.koff) * 2;
#define PG8_RSDMA(pm_, par_) do { if constexpr (Epi::RS) if (wid == 0) { const char* sp_ = (const char*)E.ssq + ((size_t)(pm_) * BM + lane * 2) * 8; \
        __builtin_amdgcn_global_load_lds((const unsigned*)sp_, (LAS unsigned*)(lds + STAGE_BYTES + (par_) * 2048), 16, 0, 0); \
        __builtin_amdgcn_global_load_lds((const unsigned*)(sp_ + 1024), (LAS unsigned*)(lds + STAGE_BYTES + (par_) * 2048 + 1024), 16, 0, 0); } } while (0)
    PG8_RSDMA(cur.pm, 0);
    PG8_STAGE(PG8_SB(0, 0), cB, voffB); PG8_STAGE(PG8_SB(0, 1), cB + hstepB, voffB); PG8_STAGE(PG8_SA(0, 0), cA, voffA); PG8_STAGE(PG8_SA(0, 1), cA + hstepA, voffA);
    if (wr == 1) PG8_BAR;
    PG8_WAIT_V(2); PG8_BAR;
    PG8_STAGE(PG8_SB(1, 0), cB + kstep, voffB); PG8_STAGE(PG8_SA(1, 0), cA + kstep, voffA); PG8_STAGE(PG8_SB(1, 1), cB + hstepB + kstep, voffB);
    PG8_WAIT_V(6); PG8_BAR;
    for (;;) {
        const bool has_next = S.next(ui + 1, nxt);
        const char* nA = has_next ? (const char*)g.A + ((size_t)nxt.pm * BM * lda + nxt.koff) * 2 : cA; const char* nB = has_next ? (const char*)g.Bt + ((size_t)nxt.pn * BM * ldb + nxt.koff) * 2 : cB;
        const int nt = cur.nt;
        for (int t = 0; t < nt; t += 2) {
            const bool last = (t == nt - 2);
            if (last && has_next) PG8_RSDMA(nxt.pm, (ui + 1) & 1);
            const char* a1 = cA + (size_t)(t + 1) * kstep;
            const char* a2 = last ? nA : cA + (size_t)(t + 2) * kstep; const char* b2 = last ? nB : cB + (size_t)(t + 2) * kstep;
            const char* a3 = a2 + kstep; const char* b3 = b2 + kstep;
            PG8_LDB(B0, 0, 0); PG8_LDB(B1, 0, 1); PG8_SCHED; PG8_LDA(At, 0, 0); PG8_STAGE(PG8_SA(1, 1), a1 + hstepA, voffA);
            PG8_WAIT_V(8); PG8_WAIT_L(0); PG8_BAR; PG8_MMA(0, 0, At, B0); PG8_MMA(0, 1, At, B1); PG8_BAR; PG8_SCHED;
            PG8_LDA(At, 0, 1); PG8_STAGE(PG8_SB(0, 0), b2, voffB); PG8_STAGE(PG8_SB(0, 1), b2 + hstepB, voffB); PG8_STAGE(PG8_SA(0, 0), a2, voffA);
            PG8_WAIT_V(8); PG8_WAIT_L(0); PG8_BAR; PG8_MMA(1, 0, At, B0); PG8_MMA(1, 1, At, B1); PG8_BAR; PG8_SCHED;
            PG8_LDB(B0, 1, 0); PG8_LDB(B1, 1, 1); PG8_SCHED; PG8_LDA(At, 1, 0); PG8_STAGE(PG8_SA(0, 1), a2 + hstepA, voffA);
            PG8_WAIT_V(8); PG8_WAIT_L(0); PG8_BAR; PG8_MMA(0, 0, At, B0); PG8_MMA(0, 1, At, B1); PG8_BAR; PG8_SCHED;
            PG8_LDA(At, 1, 1); PG8_STAGE(PG8_SB(1, 0), b3, voffB); PG8_STAGE(PG8_SB(1, 1), b3 + hstepB, voffB); PG8_STAGE(PG8_SA(1, 0), a3, voffA);
            PG8_WAIT_V(8); PG8_WAIT_L(0); PG8_BAR; PG8_MMA(1, 0, At, B0); PG8_MMA(1, 1, At, B1); PG8_BAR; PG8_SCHED;
        }
        if constexpr (ALIGN_EPI) { if (wr == 0) PG8_BAR; }
        const bool keep = E(acc, cur, wr, wc, fr, fq, (const LAS u64*)(lds + STAGE_BYTES + (ui & 1) * 2048));
        if (!has_next) break;
        if (!keep) {
#pragma unroll
        for (int a = 0; a < 2; ++a)
#pragma unroll
            for (int b = 0; b < 2; ++b)
#pragma unroll
                for (int m = 0; m < 4; ++m)
#pragma unroll
                    for (int n = 0; n < 2; ++n) acc[a][b][m][n] = (f32x4){0.f, 0.f, 0.f, 0.f};
        }
        cur = nxt; cA = nA; cB = nB; ++ui;
        if constexpr (ALIGN_EPI) { if (wr == 1) PG8_BAR; }
    }
    PG8_WAIT_V(0);
    if constexpr (!ALIGN_EPI) { if (wr == 0) PG8_BAR; }
    PG8_BAR;
#undef PG8_RSDMA
#undef PG8_SA
#undef PG8_SB
#undef PG8_STAGE
#undef PG8_LDA
#undef PG8_LDB
#undef PG8_MMA
#undef PG8_WAIT_V
#undef PG8_WAIT_L
#undef PG8_BAR
#undef PG8_SCHED
}

typedef f32x4 Acc[2][2][4][2];
struct EpiProj {
    static constexpr bool PERM = true, RS = true;
    bf16_t* O; const u64* ssq;
    __device__ __forceinline__ bool operator()(Acc& acc, const Unit& u, int wr, int wc, int fr, int fq, const LAS u64* rstab) const {
        const int row0 = u.pm * BM + wr * 64 + fr, col0 = u.pn * BM + wc * 32 + 8 * fq;
        const int kind = (u.pn >= GOFF / 256) ? 2 : ((u.pn >= QOFF / 256 && u.pn < KOFF / 256) ? 1 : 0);
#pragma unroll
        for (int ai = 0; ai < 2; ++ai)
#pragma unroll
            for (int m = 0; m < 4; ++m) { const int row = row0 + ai * HALF + m * 16;
                float rs = __builtin_amdgcn_rsqf((float)rstab[row - u.pm * BM] * (1.0f / 16777216.0f / DM) + RMS_EPS); if (kind == 1) rs *= 0.125f;
                bf16_t* rowp = O + (size_t)row * NINP + col0;
#pragma unroll
                for (int bj = 0; bj < 2; ++bj) { f32x4 v0 = acc[ai][bj][m][0] * rs, v1 = acc[ai][bj][m][1] * rs;
                    if (kind == 2) {
#pragma unroll
                        for (int j = 0; j < 4; ++j) { v0[j] = sigmoidf_(v0[j]); v1[j] = sigmoidf_(v1[j]); } }
                    u32x4 w; w.x = cvt_pk_bf16(v0[0], v0[1]); w.y = cvt_pk_bf16(v0[2], v0[3]); w.z = cvt_pk_bf16(v1[0], v1[1]); w.w = cvt_pk_bf16(v1[2], v1[3]);
                    *(u32x4*)(rowp + bj * HALF) = w; } }
        return false;
    }
};
struct EpiMlpIn {
    static constexpr bool PERM = true, RS = true;
    bf16_t* O; const u64* ssq;
    __device__ __forceinline__ bool operator()(Acc& acc, const Unit& u, int wr, int wc, int fr, int fq, const LAS u64* rstab) const {
        const int row0 = u.pm * BM + wr * 64 + fr, col0 = u.pn * BM + wc * 32 + 8 * fq;
#pragma unroll
        for (int ai = 0; ai < 2; ++ai)
#pragma unroll
            for (int m = 0; m < 4; ++m) { const int row = row0 + ai * HALF + m * 16;
                const float rs = __builtin_amdgcn_rsqf((float)rstab[row - u.pm * BM] * (1.0f / 16777216.0f / DM) + RMS_EPS);
                bf16_t* rowp = O + (size_t)row * DFF + col0;
#pragma unroll
                for (int bj = 0; bj < 2; ++bj) { f32x4 v0 = acc[ai][bj][m][0] * rs, v1 = acc[ai][bj][m][1] * rs;
#pragma unroll
                    for (int j = 0; j < 4; ++j) { const float a = fmaxf(v0[j], 0.f), b = fmaxf(v1[j], 0.f); v0[j] = a * a; v1[j] = b * b; }
                    u32x4 w; w.x = cvt_pk_bf16(v0[0], v0[1]); w.y = cvt_pk_bf16(v0[2], v0[3]); w.z = cvt_pk_bf16(v1[0], v1[1]); w.w = cvt_pk_bf16(v1[2], v1[3]);
                    *(u32x4*)(rowp + bj * HALF) = w; } }
        return false;
    }
};
template <bool BASE_F32> struct EpiResid {
    static constexpr bool PERM = true, RS = false;
    const void* base; bf16_t* HB; u64* ssq;
    __device__ __forceinline__ bool operator()(Acc& acc, const Unit& u, int wr, int wc, int fr, int fq, const LAS u64* rstab) const {
        const int row0 = u.pm * BM + wr * 64 + fr, col0 = u.pn * BM + wc * 32 + 8 * fq;
#pragma unroll
        for (int ai = 0; ai < 2; ++ai) {
            f32x4 bb[4][2][2];
#pragma unroll
            for (int m = 0; m < 4; ++m)
#pragma unroll
                for (int bj = 0; bj < 2; ++bj) { const size_t off = (size_t)(row0 + ai * HALF + m * 16) * DM + col0 + bj * HALF;
                    if (BASE_F32) { bb[m][bj][0] = *(const f32x4*)((const float*)base + off); bb[m][bj][1] = *(const f32x4*)((const float*)base + off + 4); }
                    else { const u32x4 w = *(const u32x4*)((const bf16_t*)base + off); bb[m][bj][0] = (f32x4){bf_lo(w.x), bf_hi(w.x), bf_lo(w.y), bf_hi(w.y)}; bb[m][bj][1] = (f32x4){bf_lo(w.z), bf_hi(w.z), bf_lo(w.w), bf_hi(w.w)}; } }
            __builtin_amdgcn_sched_barrier(0);
#pragma unroll
            for (int m = 0; m < 4; ++m) { const int row = row0 + ai * HALF + m * 16; float s = 0.f;
#pragma unroll
                for (int bj = 0; bj < 2; ++bj) { const size_t off = (size_t)row * DM + col0 + bj * HALF;
                    const f32x4 a0 = acc[ai][bj][m][0], a1 = acc[ai][bj][m][1]; float o[8];
#pragma unroll
                    for (int j = 0; j < 4; ++j) { o[j] = bb[m][bj][0][j] + a0[j]; o[4 + j] = bb[m][bj][1][j] + a1[j]; }
#pragma unroll
                    for (int j = 0; j < 8; ++j) s += o[j] * o[j];
                    *(u32x4*)(HB + off) = pack8(o); }
                s += __shfl_xor(s, 16); s += __shfl_xor(s, 32);
                if (fq == 0) ssq_add(ssq + row, s); } }
        return false;
    }
};
struct EpiBranch {
    static constexpr bool PERM = true, RS = false;
    bf16_t* O; const bf16_t* proj;
    __device__ __forceinline__ bool operator()(Acc& acc, const Unit& u, int wr, int wc, int fr, int fq, const LAS u64* rstab) const {
        const int row0 = u.pm * BM + wr * 64 + fr, col0 = u.pn * BM + wc * 32 + 8 * fq;
        if (u.tag == 0) {
#pragma unroll
            for (int ai = 0; ai < 2; ++ai) { u32x4 gr[4][2], ga[4][2];
#pragma unroll
                for (int m = 0; m < 4; ++m)
#pragma unroll
                    for (int bj = 0; bj < 2; ++bj) { const bf16_t* gp = proj + (size_t)(row0 + ai * HALF + m * 16) * NINP + GOFF + col0 + bj * HALF; gr[m][bj] = *(const u32x4*)gp; ga[m][bj] = *(const u32x4*)(gp + DM); }
                __builtin_amdgcn_sched_barrier(0);
#pragma unroll
                for (int m = 0; m < 4; ++m)
#pragma unroll
                    for (int bj = 0; bj < 2; ++bj) { float r8[8], a8[8]; unpack8(gr[m][bj], r8); unpack8(ga[m][bj], a8);
#pragma unroll
                        for (int j = 0; j < 4; ++j) { acc[ai][bj][m][0][j] *= a8[j] * __builtin_amdgcn_rcpf(r8[j]); acc[ai][bj][m][1][j] *= a8[4 + j] * __builtin_amdgcn_rcpf(r8[4 + j]); } } }
            return true;
        }
#pragma unroll
        for (int ai = 0; ai < 2; ++ai) { u32x4 gr[4][2];
#pragma unroll
            for (int m = 0; m < 4; ++m)
#pragma unroll
                for (int bj = 0; bj < 2; ++bj) gr[m][bj] = *(const u32x4*)(proj + (size_t)(row0 + ai * HALF + m * 16) * NINP + GOFF + col0 + bj * HALF);
            __builtin_amdgcn_sched_barrier(0);
#pragma unroll
            for (int m = 0; m < 4; ++m)
#pragma unroll
                for (int bj = 0; bj < 2; ++bj) { float r8[8]; unpack8(gr[m][bj], r8); const f32x4 v0 = acc[ai][bj][m][0], v1 = acc[ai][bj][m][1];
                    u32x4 w; w.x = cvt_pk_bf16(v0[0] * r8[0], v0[1] * r8[1]); w.y = cvt_pk_bf16(v0[2] * r8[2], v0[3] * r8[3]); w.z = cvt_pk_bf16(v1[0] * r8[4], v1[1] * r8[5]); w.w = cvt_pk_bf16(v1[2] * r8[6], v1[3] * r8[7]);
                    *(u32x4*)(O + (size_t)(row0 + ai * HALF + m * 16) * DM + col0 + bj * HALF) = w; } }
        return false;
    }
};
struct EpiLora {
    static constexpr bool PERM = false, RS = false;
    unsigned char* act; const float *w0, *a0;
    __device__ __forceinline__ bool operator()(Acc& acc, const Unit& u, int wr, int wc, int fr, int fq, const LAS u64* rstab) const {
        const int row0 = u.pm * BM + wr * 64 + fr, cb = u.tag, c0 = (u.pn & 3) * BM + wc * 32 + 4 * fq;
        const size_t eo = (size_t)row0 * RD + c0;
        bf16_t* Ob = (bf16_t*)(act + (cb == 0 ? A_G : (cb <= 2 ? A_WF + (size_t)(cb - 1) * F32RD : A_AF + (size_t)(cb - 3) * F32RD))) + eo;
        const float* pv = (cb >= 3 ? a0 + (cb - 3) * RD : w0 + (cb == 2 ? RD : 0)) + c0;
        if (cb == 0) {
#pragma unroll
            for (int bj = 0; bj < 2; ++bj)
#pragma unroll
                for (int n = 0; n < 2; ++n)
#pragma unroll
                    for (int ai = 0; ai < 2; ++ai)
#pragma unroll
                        for (int m = 0; m < 4; ++m) { const f32x4 a = acc[ai][bj][m][n]; const size_t oo = (size_t)(ai * HALF + m * 16) * RD + bj * HALF + n * 16;
                            u32x2 w; w.x = cvt_pk_bf16(a[0], a[1]); w.y = cvt_pk_bf16(a[2], a[3]); *(u32x2*)(Ob + oo) = w; }
            return false;
        }
        f32x4 p0v[2][2];
#pragma unroll
        for (int bj = 0; bj < 2; ++bj)
#pragma unroll
            for (int n = 0; n < 2; ++n) p0v[bj][n] = *(const f32x4*)(pv + bj * HALF + n * 16);
        __builtin_amdgcn_sched_barrier(0);
        const float osc = (cb <= 2) ? -0.87503878f : 1.0f;
#pragma unroll
        for (int bj = 0; bj < 2; ++bj)
#pragma unroll
            for (int n = 0; n < 2; ++n) { const f32x4 p0 = p0v[bj][n];
#pragma unroll
                for (int ai = 0; ai < 2; ++ai)
#pragma unroll
                    for (int m = 0; m < 4; ++m) { const f32x4 a = acc[ai][bj][m][n]; f32x4 o; const size_t oo = (size_t)(ai * HALF + m * 16) * RD + bj * HALF + n * 16;
#pragma unroll
                        for (int j = 0; j < 4; ++j) o[j] = osc * sigmoidf_(p0[j] + a[j]);
                        u32x2 w; w.x = cvt_pk_bf16(o[0], o[1]); w.y = cvt_pk_bf16(o[2], o[3]); *(u32x2*)(Ob + oo) = w; } }
        return false;
    }
};
struct ProjTailSched {
    int c, nt;
    __device__ bool next(int i, Unit& u) const { if (i > 0) return false; u.pm = c; u.pn = (NINP / 256) - 1; u.koff = 0; u.nt = nt; u.tag = 0; return true; }
};
struct BranchSched : StaticOrder {
    int nt0;
    __device__ bool next(int i, Unit& u) const { if (!map(i >> 1, u.pm, u.pn)) return false; u.tag = i & 1; u.koff = u.tag == 0 ? RD : 0; u.nt = u.tag == 0 ? nt0 : 2 * nt0; return true; }
};
struct LoraSched : StaticOrder {
    int nt;
    __device__ bool next(int i, Unit& u) const { if (!map(i, u.pm, u.pn)) return false; u.tag = u.pn >> 2; u.koff = u.tag == 0 ? 0 : (u.tag <= 2 ? 256 : 448); u.nt = nt; return true; }
};
}

#define XB_TMO      128
#define XB_XCNT(j)  (256  + 64 * (j))
#define XB_XSUB(j)  (1280 + 64 * (j))
#define XB_XGEN(j)  (2304 + 64 * (j))
#define XB_TOP      3328
#define XB_TOPGEN   3392
#define XCD_BAR_WORDS 3456
#define XB_SPIN_CAP (1u << 21)
__device__ __forceinline__ unsigned xb_ld(unsigned* p)              { return __hip_atomic_load(p, __ATOMIC_RELAXED, __HIP_MEMORY_SCOPE_AGENT); }
__device__ __forceinline__ unsigned xb_add(unsigned* p, unsigned v) { return __hip_atomic_fetch_add(p, v, __ATOMIC_RELAXED, __HIP_MEMORY_SCOPE_AGENT); }
__device__ __forceinline__ unsigned xb_xcc_id() { return (unsigned)__builtin_amdgcn_s_getreg((3 << 11) | 20) & 0xFu; }
#define XB_SPIN(cond, bar) do { unsigned _sp = 0; while (cond) { __builtin_amdgcn_s_sleep(1); \
    if ((++_sp & 255u) == 0u) { if (xb_ld(&(bar)[XB_TMO])) break; if (_sp > XB_SPIN_CAP) { atomicAdd(&(bar)[XB_TMO], 1u); break; } } } } while (0)
struct XcdBarrier { unsigned* bar; unsigned x; volatile LAS unsigned* st; };
__device__ __forceinline__ XcdBarrier xcd_barrier_post(unsigned* bar, volatile LAS unsigned* st) {
    XcdBarrier b; b.bar = bar; b.x = xb_xcc_id(); b.st = st;
    if (threadIdx.x == 0) (void)xb_add(&bar[XB_XCNT(b.x)], 1u);
    return b;
}
__device__ __forceinline__ void xcd_barrier_complete(unsigned* bar, unsigned x, unsigned& nloc, unsigned& nx) {
    const unsigned G = gridDim.x * gridDim.y * gridDim.z;
    unsigned sum, cnt, mine, sp = 0u;
    for (;;) {
        sum = 0u; cnt = 0u; mine = 0u;
#pragma unroll
        for (unsigned j = 0; j < 16; ++j) { const unsigned c = xb_ld(&bar[XB_XCNT(j)]); sum += c; cnt += (c > 0u) ? 1u : 0u; mine = (j == x) ? c : mine; }
        if (sum == G) break;
        __builtin_amdgcn_s_sleep(1);
        if ((++sp & 255u) == 0u) { if (xb_ld(&bar[XB_TMO])) break; if (sp > XB_SPIN_CAP) { atomicAdd(&bar[XB_TMO], 1u); break; } }
    }
    nloc = mine > 0u ? mine : 1u; nx = cnt > 0u ? cnt : 1u;
}
__device__ __forceinline__ void xcd_barrier(const XcdBarrier& b) {
    asm volatile("s_waitcnt vmcnt(0)" ::: "memory");
    __syncthreads();
    if (threadIdx.x == 0) {
        unsigned* bar = b.bar;
        __builtin_amdgcn_s_waitcnt(0);
        unsigned nloc = b.st[0], nx = b.st[1];
        if (nloc == 0u) { xcd_barrier_complete(bar, b.x, nloc, nx); b.st[0] = nloc; b.st[1] = nx; }
        const unsigned old = xb_add(&bar[XB_XSUB(b.x)], 1u);
        const unsigned gen = old / nloc;
        if (old + 1u == (gen + 1u) * nloc) {
            __builtin_amdgcn_fence(__ATOMIC_RELEASE, "agent");
            asm volatile("s_waitcnt vmcnt(0)" ::: "memory");
            const unsigned og = xb_add(&bar[XB_TOP], 1u);
            const unsigned tg = og / nx;
            if (og + 1u == (tg + 1u) * nx) xb_add(&bar[XB_TOPGEN], 1u);
            else XB_SPIN(xb_ld(&bar[XB_TOPGEN]) == tg, bar);
            __builtin_amdgcn_fence(__ATOMIC_ACQUIRE, "agent");
            xb_add(&bar[XB_XGEN(b.x)], 1u);
            asm volatile("s_waitcnt vmcnt(0)" ::: "memory");
        } else {
            XB_SPIN(xb_ld(&bar[XB_XGEN(b.x)]) == gen, bar);
            __builtin_amdgcn_fence(__ATOMIC_ACQUIRE, "agent");
            asm volatile("s_waitcnt vmcnt(0)" ::: "memory");
        }
    }
    __syncthreads();
}

#define XB_EXIT 3520
__device__ unsigned g_bar[4096];
struct Args {
    const float* in[22]; float* out; unsigned char* ws; int ph_lo, ph_hi;
};
struct Frame {
    LAS unsigned char* lds; int tid, lane, wave, G, gw, NGW, bx;
    unsigned char* ws;
};

template <class T> __device__ __forceinline__ T* launder(T* p) {
    unsigned long long v = (unsigned long long)p; unsigned lo = __builtin_amdgcn_readfirstlane((unsigned)v), hi = __builtin_amdgcn_readfirstlane((unsigned)(v >> 32));
    asm volatile("" : "+s"(lo), "+s"(hi)); return (T*)(GAS T*)(((unsigned long long)hi << 32) | lo);
}
__device__ __forceinline__ float wave_sum(float v) {
#pragma unroll
    for (int o = 1; o < 64; o <<= 1) v += __shfl_xor(v, o);
    return v;
}

struct TJob { const float* W; bf16_t* WT; const float* ksc; int N, ldk, n_split, n_shift, k0, n0; bool ok; };
__device__ __forceinline__ TJob tjob(const float* W, int N, bf16_t* WT, int ldk, int n_split, int n_shift, const float* ksc, int item) {
    const int nblk = N / 32, kb = item / nblk, nb = item % nblk; return TJob{W, WT, ksc, N, ldk, n_split, n_shift, 64 * kb, 32 * nb, true}; }
__device__ __forceinline__ void t_load(const TJob& j, f32x4 (&w)[8], float (&g)[8], int lane) {
    const int kr = lane >> 3, nq = (lane & 7) * 4;
#pragma unroll
    for (int i = 0; i < 8; ++i) w[i] = __builtin_nontemporal_load((const f32x4*)(j.W + (size_t)(j.k0 + kr + 8 * i) * j.N + j.n0 + nq));
    if (j.ksc) {
#pragma unroll
        for (int i = 0; i < 8; ++i) g[i] = j.ksc[j.k0 + kr + 8 * i]; }
    else {
#pragma unroll
        for (int i = 0; i < 8; ++i) g[i] = 1.0f; }
}
__device__ __forceinline__ void t_finish(const TJob& j, const f32x4 (&w)[8], const float (&g)[8], LAS float* scr, int lane) {
    { const int kr = lane >> 3, nq = (lane & 7) * 4;
#pragma unroll
      for (int i = 0; i < 8; ++i) { const int kk = kr + 8 * i; const f32x4 v = w[i] * g[i];
          scr[kk * 33 + nq] = v[0]; scr[kk * 33 + nq + 1] = v[1]; scr[kk * 33 + nq + 2] = v[2]; scr[kk * 33 + nq + 3] = v[3]; } }
    asm volatile("s_waitcnt lgkmcnt(0)" ::: "memory");
    const int c = lane & 7;
#pragma unroll
    for (int q = 0; q < 4; ++q) { const int n = (lane >> 3) + 8 * q; const LAS float* sp = scr + (8 * c) * 33 + n;
        u32x4 o; o.x = cvt_pk_bf16(sp[0 * 33], sp[1 * 33]); o.y = cvt_pk_bf16(sp[2 * 33], sp[3 * 33]); o.z = cvt_pk_bf16(sp[4 * 33], sp[5 * 33]); o.w = cvt_pk_bf16(sp[6 * 33], sp[7 * 33]);
        const int nn = j.n0 + n; const int nr = nn < j.n_split ? nn : nn + j.n_shift;
        __builtin_nontemporal_store(o, (u32x4*)(j.WT + (size_t)nr * j.ldk + j.k0 + 8 * c)); }
    asm volatile("s_waitcnt lgkmcnt(0)" ::: "memory");
}
template <class Dec>
__device__ __forceinline__ void t_stream(const Dec& dec, LAS float* scr, int lane) {
    int n = 0; TJob ja = dec(n); if (!ja.ok) return;
    f32x4 wa[8], wb[8]; float ga[8], gb[8];
    t_load(ja, wa, ga, lane);
    for (;;) {
        const TJob jb = dec(n + 1); if (jb.ok) t_load(jb, wb, gb, lane);
        t_finish(ja, wa, ga, scr, lane);
        if (!jb.ok) break;
        ja = dec(n + 2); if (ja.ok) t_load(ja, wa, ga, lane);
        t_finish(jb, wb, gb, scr, lane);
        if (!ja.ok) break;
        n += 2;
    }
}
__device__ __forceinline__ int t5_bucket(int rel) {
    const int ret = rel > 0 ? 16 : 0; const int n = rel < 0 ? -rel : rel;
    if (n < 8) return ret + n;
    int large = 8 + (int)(logf((float)n / 8.0f) / 4.852030263919617f * 8.0f);
    if (large > 15) large = 15;
    return ret + large;
}
__device__ __forceinline__ void convert_weights(const Args& AR, unsigned char* ws, int l, int sel, int wi, int nw, LAS float* scr, int lane, int q0, int q1, int wcount = 1, int ewi = -1, int enw = 0) {
    const int qc = q1 - q0;
    if (ewi < 0) { ewi = wi; enw = nw; }
    unsigned char* wl = ws + WS_W + (size_t)l * W_LAYER_B;
    constexpr int I_IN = (DM / 64) * (NIN / 32), I_BR = (RD / 64) * (DM / 32), I_BA = (AOD / 64) * (DM / 32), I_OUT = (DM / 64) * (DM / 32), I_MI = (DM / 64) * (DFF / 32), I_MO = (DFF / 64) * (DM / 32);
    if (sel & 1) {
        const float* w_in = AR.in[2] + (size_t)l * DM * NIN; const float* n1 = AR.in[1] + l * DM;
        t_stream([&](int n) { const int sx = wi + (n / wcount) * nw + (n % wcount); const int it = (sx / qc) * 8 + q0 + (sx % qc);
                      if (it >= I_IN) { TJob z{}; z.ok = false; return z; }
                      return tjob(w_in, NIN, (bf16_t*)(wl + WO_IN), DM, RWKV_COLS, SLABP - RWKV_COLS, n1, it); }, scr, lane);
        const int gt = ewi * 64 + lane, nth = enw * 64;
        if (q1 == 8) { bf16_t* z = (bf16_t*)(wl + WO_IN) + (size_t)RWKV_COLS * DM;
          unsigned zz; asm volatile("v_mov_b32 %0, 0" : "=v"(zz));
          for (int i = gt; i < (SLABP - RWKV_COLS) * DM / 8; i += nth) *(u32x4*)(z + (size_t)i * 8) = (u32x4){zz, zz, zz, zz}; }
        if (q1 == 8) { bf16_t* Bl = (bf16_t*)(wl + WO_LORA);
          const float* gup = AR.in[8] + (size_t)l * 256 * RD; const float* wup = AR.in[5] + (size_t)l * 2 * 96 * RD; const float* aup = AR.in[7] + (size_t)l * 2 * 96 * RD;
          for (int i = gt; i < LORA_N * (LORA_K / 8); i += nth) {
              const int kc = i / LORA_N, n = i % LORA_N, cb = n >> 10, c = n & 1023, k0 = kc * 8;
              const int lo = cb == 0 ? 0 : 160 + 96 * cb, len = cb == 0 ? 256 : 96;
              const float* src = cb == 0 ? gup : (cb < 3 ? wup + (size_t)(cb - 1) * 96 * RD : aup + (size_t)(cb - 3) * 96 * RD);
              u32x4 o = (u32x4){0u, 0u, 0u, 0u};
              if (k0 >= lo && k0 < lo + len) { const float* sp = src + (size_t)(k0 - lo) * RD + c; float f[8];
#pragma unroll
                  for (int j = 0; j < 8; ++j) f[j] = sp[(size_t)j * RD];
                  o = pack8(f); }
              *(u32x4*)(Bl + (size_t)n * LORA_K + k0) = o; } }
    }
    if (sel & 2) {
        const float* wbr = AR.in[15] + (size_t)l * RD * DM; const float* wba = AR.in[16] + (size_t)l * AOD * DM; const float* wout = AR.in[17] + (size_t)l * DM * DM;
        const float* n2 = AR.in[18] + l * DM; const float* wmi = AR.in[19] + (size_t)l * DM * DFF; const float* wmo = AR.in[20] + (size_t)l * DFF * DM;
        constexpr int NITEMS = I_BR + I_BA + I_OUT + I_MI + I_MO;
        t_stream([&](int n) { const int sx = wi + (n / wcount) * nw + (n % wcount); const int it = (sx / qc) * 8 + q0 + (sx % qc);
                      if (it >= NITEMS) { TJob z{}; z.ok = false; return z; }
                      int r = it;
                      if (r < I_BR) return tjob(wbr, DM, (bf16_t*)(wl + WO_BR), OCAT, 1 << 30, 0, nullptr, r); r -= I_BR;
                      if (r < I_BA) return tjob(wba, DM, (bf16_t*)(wl + WO_BR) + RD, OCAT, 1 << 30, 0, nullptr, r); r -= I_BA;
                      if (r < I_OUT) return tjob(wout, DM, (bf16_t*)(wl + WO_OUT), DM, 1 << 30, 0, nullptr, r); r -= I_OUT;
                      if (r < I_MI) return tjob(wmi, DFF, (bf16_t*)(wl + WO_MI), DM, 1 << 30, 0, n2, r); r -= I_MI;
                      return tjob(wmo, DM, (bf16_t*)(wl + WO_MO), DFF, 1 << 30, 0, nullptr, r); }, scr, lane);
    }
}
__device__ __forceinline__ void p0_prologue(const Args& AR, Frame& F) {
    convert_weights(AR, F.ws, 0, 1, F.gw, F.NGW, (LAS float*)(F.lds + F.wave * 16384), F.lane, 0, 8);
    const float* x = AR.in[0]; bf16_t* HB = (bf16_t*)(F.ws + WS_ACT + A_HB); u64* ssqA = (u64*)(F.ws + WS_SSQA);
    for (int m = F.gw; m < M; m += F.NGW) {
        const f32x4* xr = (const f32x4*)(x + (size_t)m * DM) + F.lane; float s = 0.f; f32x4 xv[8];
#pragma unroll
        for (int j = 0; j < 8; ++j) xv[j] = xr[64 * j];
#pragma unroll
        for (int j = 0; j < 8; ++j) { const f32x4 v = xv[j]; s += (v[0] * v[0] + v[1] * v[1]) + (v[2] * v[2] + v[3] * v[3]);
            u32x2 w; w.x = cvt_pk_bf16(v[0], v[1]); w.y = cvt_pk_bf16(v[2], v[3]); *(u32x2*)(HB + (size_t)m * DM + (64 * j + F.lane) * 4) = w; }
        s = wave_sum(s); if (F.lane == 0) ssqA[m] = (u64)(s * 16777216.0f + 0.5f);
    }
    if (F.bx == 0) { float* bt = (float*)(F.ws + WS_BTAB); const float* rb = AR.in[14];
        for (int i = F.tid; i < AH * 256; i += NTHREADS) { const int h = i >> 8, j = (i & 255) - 64, g = h >> 3, dil = g == 0 ? 1 : (g == 1 ? 4 : 16);
            bt[i] = (j >= 0 && j <= 128) ? rb[t5_bucket((j - 64) * dil) * AH + h] : 0.f; } }
}

__device__ __forceinline__ void phase_shift(const Args& AR, Frame& F, int l) {
    const bf16_t* proj = (const bf16_t*)(F.ws + WS_ACT + A_PROJ);
    bf16_t* R = (bf16_t*)(F.ws + WS_ACT + A_R); bf16_t* K = (bf16_t*)(F.ws + WS_ACT + A_K); bf16_t* V = (bf16_t*)(F.ws + WS_ACT + A_V); bf16_t* KK = (bf16_t*)(F.ws + WS_ACT + A_KK);
    bf16_t* LIN = (bf16_t*)(F.ws + WS_ACT + A_LIN);
    const float* mu = AR.in[3] + (size_t)l * RWKV_COLS; const float* k_k = AR.in[9] + (size_t)l * RD;
    f32x4 muv[8][2], kkv[2][2];
#pragma unroll
    for (int j = 0; j < 8; ++j) { const int cl = min(F.lane + 64 * j, 463) * 8; muv[j][0] = *(const f32x4*)(mu + cl); muv[j][1] = *(const f32x4*)(mu + cl + 4); }
#pragma unroll
    for (int j = 0; j < 2; ++j) { const int cc = ((F.lane + 64 * (2 + j)) & 127) * 8; kkv[j][0] = *(const f32x4*)(k_k + cc); kkv[j][1] = *(const f32x4*)(k_k + cc + 4); }
    for (int m = F.gw; m < M; m += F.NGW) {
        const int t = m % SEQ; const float fp = t > 0 ? 0.5f : 0.f, fn = t < SEQ - 1 ? 0.5f : 0.f;
        const bf16_t* row = proj + (size_t)m * NINP; const bf16_t* prow = t > 0 ? row - NINP : row; const bf16_t* nrow = t < SEQ - 1 ? row + NINP : row;
        u32x4 cw[8], pw[8], nw[8];
#pragma unroll
        for (int j = 0; j < 8; ++j) { const int cl = min(F.lane + 64 * j, 463) * 8; cw[j] = *(const u32x4*)(row + cl); pw[j] = *(const u32x4*)(prow + cl); nw[j] = *(const u32x4*)(nrow + cl); }
#pragma unroll
        for (int j = 0; j < 8; ++j) { const int ci = F.lane + 64 * j;
            if (j < 7 || ci < 464) {
                float c[8], p[8], nx[8], o[8]; unpack8(cw[j], c); unpack8(pw[j], p); unpack8(nw[j], nx);
                const f32x4 m0 = muv[j][0], m1 = muv[j][1];
#pragma unroll
                for (int e = 0; e < 8; ++e) { const float mm = e < 4 ? m0[e] : m1[e - 4]; o[e] = c[e] + mm * ((fp * p[e] + fn * nx[e]) - c[e]); }
                if (j < 6) {
                    const int cc = (ci & 127) * 8; bf16_t* dst = (j < 2 ? R : (j < 4 ? K : V)) + (size_t)m * RD + cc;
                    *(u32x4*)dst = pack8(o);
                    if (j == 2 || j == 3) {
                        const f32x4 q0 = kkv[j - 2][0], q1 = kkv[j - 2][1]; float tt[8], ss = 0.f;
#pragma unroll
                        for (int e = 0; e < 8; ++e) { tt[e] = o[e] * (e < 4 ? q0[e] : q1[e - 4]); ss += tt[e] * tt[e]; }
                        ss += __shfl_xor(ss, 1); ss += __shfl_xor(ss, 2); ss += __shfl_xor(ss, 4);
                        const float inv = 1.0f / fmaxf(sqrtf(ss), 1e-12f);
                        bf16_t* kd = KK + (size_t)m * RD + cc;
#pragma unroll
                        for (int e = 0; e < 8; ++e) tt[e] *= inv;
                        *(u32x4*)kd = pack8(tt);
                    }
                } else {
                    const int lc = (ci - 384) * 8;
                    float f[8];
#pragma unroll
                    for (int e = 0; e < 8; ++e) f[e] = ci < 416 ? sigmoidf_(o[e]) : (ci < 440 ? tanhf(o[e]) : o[e]);
                    *(u32x4*)(LIN + (size_t)m * LORA_K + lc) = pack8(f);
                }
            } else if (ci < 480) { *(u32x4*)(LIN + (size_t)m * LORA_K + (ci - 384) * 8) = (u32x4){0u, 0u, 0u, 0u}; }
        }
    }
    { LAS bf16_t* T = (LAS bf16_t*)(F.lds + F.wave * 16640);
      bf16_t* VT = (bf16_t*)(F.ws + WS_ACT + A_VT);
      for (int it = F.gw; it < BATCH * AH * 32; it += F.NGW) {
          const int tile = it & 31, head = (it >> 5) % AH, b = it / (32 * AH), g = head >> 3, dil = g == 0 ? 1 : (g == 1 ? 4 : 16), L = SEQ / dil;
          const bf16_t* src = proj + (size_t)(b * SEQ + tile * 128) * NINP + VOFF + head * HD;
#pragma unroll 4
          for (int i = 0; i < 16; ++i) { const int tl = 8 * i + (F.lane >> 3), dc = F.lane & 7; const u32x4 w = *(const u32x4*)(src + (size_t)tl * NINP + dc * 8);
              const unsigned ww[4] = {w.x, w.y, w.z, w.w};
#pragma unroll
              for (int e = 0; e < 8; ++e) T[(dc * 8 + e) * 130 + tl] = (bf16_t)((e & 1) ? (ww[e >> 1] >> 16) : (ww[e >> 1] & 0xffffu)); }
          asm volatile("s_waitcnt lgkmcnt(0)" ::: "memory");
          const int P = 128 / dil, cpr = P / 8;
#pragma unroll 4
          for (int i = 0; i < 16; ++i) { const int q = i * 64 + F.lane, d = q >> 4, oc = q & 15, rr = oc / cpr, pc = oc % cpr; unsigned short e8[8];
#pragma unroll
              for (int e = 0; e < 8; ++e) { const int q = (pc & 1) * 8 + e, sp = dil == 16 ? e : (pc >> 1) * 16 + ((q & 3) | ((q & 8) >> 1) | ((q & 4) << 1));
                  e8[e] = T[d * 130 + sp * dil + rr]; }
              u32x4 w; w.x = e8[0] | ((unsigned)e8[1] << 16); w.y = e8[2] | ((unsigned)e8[3] << 16); w.z = e8[4] | ((unsigned)e8[5] << 16); w.w = e8[6] | ((unsigned)e8[7] << 16);
              bf16_t* vrow = VT + ((size_t)(b * AH + head) * HD + d) * SEQ + (size_t)rr * L;
              if (dil == 16) { bf16_t* gp = vrow + (tile >> 1) * 16 + 4 * (tile & 1);
                  *(u32x2*)gp = (u32x2){w.x, w.y}; *(u32x2*)(gp + 8) = (u32x2){w.z, w.w}; }
              else *(u32x4*)(vrow + tile * P + pc * 8) = w; }
          asm volatile("s_waitcnt lgkmcnt(0)" ::: "memory");
      } }
}

__device__ __forceinline__ void phase_attn(Frame& F, int aw, int naw) {
    const bf16_t* proj = (const bf16_t*)(F.ws + WS_ACT + A_PROJ); const bf16_t* VT = (const bf16_t*)(F.ws + WS_ACT + A_VT);
    const float* btab = (const float*)(F.ws + WS_BTAB);
    bf16_t* OG = (bf16_t*)(F.ws + WS_ACT + A_OG); float* LSE = (float*)(F.ws + WS_ACT + A_LSE);
    const int lane = F.lane, c32 = lane & 31, h = lane >> 5;
    for (int task = aw; task < BATCH * AH * 128; task += naw) {
        const int qt = task & 127, head = (task >> 7) % AH, b = task / (128 * AH), g = head >> 3, dil = g == 0 ? 1 : (g == 1 ? 4 : 16), L = SEQ / dil;
        const int s0 = qt * 32, r = s0 / L, pos0 = s0 % L;
        const bf16_t* base = proj + (size_t)b * SEQ * NINP + head * HD;
        f32x16 sc[5];
        { typedef float f32x4u __attribute__((ext_vector_type(4), aligned(4)));
          const float* bt = btab + head * 256 + 64 + 4 * h - c32;
#pragma unroll
          for (int kt = 0; kt < 5; ++kt)
#pragma unroll
              for (int g4 = 0; g4 < 4; ++g4) { const f32x4u bv = *(const f32x4u*)(bt + 32 * kt + 8 * g4);
#pragma unroll
                  for (int e = 0; e < 4; ++e) sc[kt][4 * g4 + e] = bv[e]; } }
        __builtin_amdgcn_sched_barrier(0);
        bf16x8 qf[4];
        { const bf16_t* qp = base + (size_t)((pos0 + c32) * dil + r) * NINP + QOFF + 8 * h;
#pragma unroll
          for (int s = 0; s < 4; ++s) qf[s] = *(const bf16x8*)(qp + 16 * s); }
        bf16x8 kfr[5][4];
#define LOAD_K(kt) do { const int kp_ = pos0 - 64 + 32 * (kt) + c32; const int kpc_ = kp_ < 0 ? 0 : (kp_ >= L ? L - 1 : kp_); const unsigned ko_ = (unsigned)((kpc_ * dil + r) * NINP + KOFF + 8 * h) * 2u; \
            _Pragma("unroll") for (int s_ = 0; s_ < 4; ++s_) kfr[kt][s_] = *(const bf16x8*)((const char*)base + (ko_ + 32u * s_)); } while (0)
        LOAD_K(0); LOAD_K(1); LOAD_K(2);
        const char* vth = (const char*)(VT + (size_t)(b * AH + head) * HD * SEQ);
        const unsigned vo0 = (unsigned)(c32 * SEQ + r * L) * 2u, vo1 = vo0 + 32u * SEQ * 2u;
        u32x4 vfa[10], vfb[10];
#define LOAD_V(ks) do { int k0 = pos0 - 64 + 16 * (ks);                                            \
            k0 = (k0 < 0 || k0 >= L) ? 0 : k0; \
            vfa[ks] = *(const u32x4*)(vth + (vo0 + 2u * k0 + 16u * h)); vfb[ks] = *(const u32x4*)(vth + (vo1 + 2u * k0 + 16u * h)); } while (0)
#pragma unroll
        for (int ks = 0; ks < 2; ++ks) LOAD_V(ks);
        __builtin_amdgcn_sched_barrier(0);
#pragma unroll
        for (int kt = 0; kt < 5; ++kt)
#pragma unroll
            for (int i = 0; i < 16; ++i) { const int krow = (i & 3) + 8 * (i >> 2) + 4 * h, kpos = pos0 - 64 + 32 * kt + krow, idx = 32 * kt + krow - c32;
                const bool ok = (idx >= 0) && (idx <= 128) && (kpos >= 0) && (kpos < L);
                sc[kt][i] = ok ? sc[kt][i] : -INFINITY; }
#pragma unroll
        for (int kt = 0; kt < 5; ++kt) {
            if (kt == 0) { LOAD_K(3); } if (kt == 1) { LOAD_K(4); }
            f32x16 a = sc[kt];
#pragma unroll
            for (int s = 0; s < 4; ++s) a = __builtin_amdgcn_mfma_f32_32x32x16_bf16(kfr[kt][s], qf[s], a, 0, 0, 0);
            sc[kt] = a;
        }
#pragma unroll
        for (int ks = 2; ks < 6; ++ks) LOAD_V(ks);
#undef LOAD_K
        __builtin_amdgcn_sched_barrier(0);
        float mx = -INFINITY;
#pragma unroll
        for (int kt = 0; kt < 5; ++kt)
#pragma unroll
            for (int i = 0; i < 16; ++i) mx = fmaxf(mx, sc[kt][i]);
        mx = fmaxf(mx, __shfl_xor(mx, 32));
        float lsum = 0.f;
#pragma unroll
        for (int kt = 0; kt < 5; ++kt)
#pragma unroll
            for (int i = 0; i < 16; ++i) { const float p = __expf(sc[kt][i] - mx); sc[kt][i] = p; lsum += p; }
        lsum += __shfl_xor(lsum, 32);
        f32x16 o0 = {}, o1 = {};
#pragma unroll
        for (int kt = 0; kt < 5; ++kt)
#pragma unroll
            for (int s = 0; s < 2; ++s) {
                if (kt == 0 && s == 0) { LOAD_V(6); LOAD_V(7); } if (kt == 1 && s == 0) { LOAD_V(8); LOAD_V(9); }
                u32x4 pw; pw.x = cvt_pk_bf16(sc[kt][8 * s + 0], sc[kt][8 * s + 1]); pw.y = cvt_pk_bf16(sc[kt][8 * s + 2], sc[kt][8 * s + 3]); pw.z = cvt_pk_bf16(sc[kt][8 * s + 4], sc[kt][8 * s + 5]); pw.w = cvt_pk_bf16(sc[kt][8 * s + 6], sc[kt][8 * s + 7]);
                const bf16x8 pf = __builtin_bit_cast(bf16x8, pw);
                o0 = __builtin_amdgcn_mfma_f32_32x32x16_bf16(__builtin_bit_cast(bf16x8, vfa[2 * kt + s]), pf, o0, 0, 0, 0);
                o1 = __builtin_amdgcn_mfma_f32_32x32x16_bf16(__builtin_bit_cast(bf16x8, vfb[2 * kt + s]), pf, o1, 0, 0, 0);
            }
#undef LOAD_V
        const float inv = 1.0f / lsum;
        const size_t tok = (size_t)b * SEQ + (size_t)(pos0 + c32) * dil + r; const int slot = head & 7;
        bf16_t* op = OG + ((size_t)g * M + tok) * AOD + slot * HD + 4 * h;
#pragma unroll
        for (int q4 = 0; q4 < 4; ++q4) { u32x2 w0, w1;
            w0.x = cvt_pk_bf16(o0[4 * q4] * inv, o0[4 * q4 + 1] * inv); w0.y = cvt_pk_bf16(o0[4 * q4 + 2] * inv, o0[4 * q4 + 3] * inv);
            w1.x = cvt_pk_bf16(o1[4 * q4] * inv, o1[4 * q4 + 1] * inv); w1.y = cvt_pk_bf16(o1[4 * q4 + 2] * inv, o1[4 * q4 + 3] * inv);
            *(u32x2*)(op + 8 * q4) = w0; *(u32x2*)(op + 32 + 8 * q4) = w1; }
        if (h == 0) LSE[((size_t)g * M + tok) * 8 + slot] = mx + __logf(lsum);
    }
}

__device__ __forceinline__ unsigned cvtpk(float lo, float hi) { return cvt_pk_bf16(lo, hi); }
__device__ __forceinline__ bf16x8 pack8v(float a0, float a1, float a2, float a3, float a4, float a5, float a6, float a7) { u32x4 w; w.x = cvtpk(a0, a1); w.y = cvtpk(a2, a3); w.z = cvtpk(a4, a5); w.w = cvtpk(a6, a7); return __builtin_bit_cast(bf16x8, w); }
__device__ __forceinline__ bf16x8 acc_frag(const f32x16& a, int ks) { return ks == 0 ? pack8v(a[0], a[1], a[2], a[3], a[4], a[5], a[6], a[7]) : pack8v(a[8], a[9], a[10], a[11], a[12], a[13], a[14], a[15]); }
#define SCAN_TOK(s_) (dir ? (SEQ - 1 - (c * SCT + (s_))) : (c * SCT + (s_)))
typedef short v4i16_t __attribute__((ext_vector_type(4)));
__device__ __forceinline__ bf16x8 tr_frag(const LAS unsigned char* p0, const LAS unsigned char* p1) {
    const v4i16_t lo = __builtin_amdgcn_ds_read_tr16_b64_v4i16((LAS v4i16_t*)p0), hi = __builtin_amdgcn_ds_read_tr16_b64_v4i16((LAS v4i16_t*)p1);
    return (bf16x8){lo[0], lo[1], lo[2], lo[3], hi[0], hi[1], hi[2], hi[3]};
}
__device__ __forceinline__ void phase_scan_prep(Frame& F, const float* k_a, const float* r_k) {
    unsigned char* act = F.ws + WS_ACT;
    const bf16_t* R = (const bf16_t*)(act + A_R); const bf16_t* V = (const bf16_t*)(act + A_V); const bf16_t* KK = (const bf16_t*)(act + A_KK);
    constexpr int CBS = 68;
    LAS float* Cb = (LAS float*)(F.lds + F.wave * 17680);
    LAS float* Lm = Cb + 33 * CBS;
    LAS float* X = Lm + 32 * 32;
    LAS float* RKl = (LAS float*)(F.lds + PARAM_OFF + F.wave * 512); LAS float* KAl = RKl + 64;
    constexpr int TS = 136;
    LAS unsigned char* TB = (LAS unsigned char*)Lm; LAS unsigned char* TK = TB + 32 * TS; LAS unsigned char* TV = (LAS unsigned char*)Cb;
    for (int vi = F.gw * 2; vi < BATCH * RH * 2 * NCHUNK; vi += (vi & 1) ? 2 * F.NGW - 1 : 1) {
        const int pr = vi >> 1, pdir = vi & 1, pc0 = pr & (NCHUNK - 1);
        const int inst = (((pr >> 7) * 2 + pdir) << 7) + (pdir ? NCHUNK - 1 - pc0 : pc0);
        int lane = F.lane; asm volatile("" : "+v"(lane));
        const int c32 = lane & 31, h = lane >> 5;
        const int trb = ((lane & 15) >> 2) * TS + (16 * ((lane >> 4) & 1) + 4 * (lane & 3)) * 2 + 4 * h * TS;
        const int c = inst & (NCHUNK - 1), dir = (inst >> 7) & 1, hh = (inst >> 8) & 15, b = inst >> 12;
        const bf16_t* W = (const bf16_t*)(act + (dir ? A_WB : A_WF)); const bf16_t* AA = (const bf16_t*)(act + (dir ? A_AB : A_AF)); const bf16_t* Kr = (const bf16_t*)(act + A_K); const float* kah = k_a + hh * HD; const float* rkh = r_k + hh * HD;
        unsigned char* fr = act + A_FR + (size_t)inst * FR_STRIDE + lane * 16;
        const size_t hb = (size_t)b * SEQ * RD + hh * HD;
#define ST_FRAG(idx, v) __builtin_nontemporal_store((v), (bf16x8*)(fr + (idx) * 1024))
#define UP4(w) ((f32x4){bf_lo((w).x), bf_hi((w).x), bf_lo((w).y), bf_hi((w).y)})
        float wv[SCT];
#pragma unroll
        for (int t = 0; t < SCT; ++t) wv[t] = bf_lo((unsigned)(W + hb + (size_t)SCAN_TOK(t) * RD)[lane]);
        const bf16_t* KKb = KK + hb; const bf16_t* AAb = AA + hb; const bf16_t* Krb = Kr + hb; const bf16_t* Rb = R + hb; const bf16_t* Vb = V + hb;
        const int rb = SCAN_TOK(c32) * RD;
        u32x2 nk[4][2], na[4][2], nr_[4][2], nq[4][2], nv[4][2];
#pragma unroll
        for (int q = 0; q < 4; ++q) { const int j0 = 16 * q + 8 * h;
#pragma unroll
            for (int e = 0; e < 2; ++e) { nk[q][e] = *(const u32x2*)(KKb + rb + j0 + 4 * e); na[q][e] = *(const u32x2*)(AAb + rb + j0 + 4 * e); nr_[q][e] = *(const u32x2*)(Krb + rb + j0 + 4 * e); nq[q][e] = *(const u32x2*)(Rb + rb + j0 + 4 * e);
                nv[q][e] = *(const u32x2*)(Vb + rb + j0 + 4 * e); } }
        const float rkv = rkh[lane], kav = kah[lane];
        __builtin_amdgcn_sched_barrier(0);
        { float cum = 0.f; Cb[lane] = 1.f; RKl[lane] = rkv; KAl[lane] = kav;
#pragma unroll
          for (int t = 0; t < SCT; ++t) { cum += wv[t]; Cb[(t + 1) * CBS + lane] = __builtin_amdgcn_exp2f(cum); } }
        asm volatile("s_waitcnt lgkmcnt(0)" ::: "memory");
        { float bsum = 0.f;
#pragma unroll
          for (int q = 0; q < 4; ++q) { const int j0 = 16 * q + 8 * h;
              u32x2 wq0 = nq[q][0], wq1 = nq[q][1], wk0 = nr_[q][0], wk1 = nr_[q][1], wa0 = na[q][0], wa1 = na[q][1];
              asm volatile("" : "+v"(wq0), "+v"(wq1), "+v"(wk0), "+v"(wk1), "+v"(wa0), "+v"(wa1));
              const f32x4 r0 = UP4(wq0), r1 = UP4(wq1), k0 = UP4(wk0), k1 = UP4(wk1), a0 = UP4(wa0), a1 = UP4(wa1);
              const f32x4 ka0 = *(const LAS f32x4*)(KAl + j0), ka1 = *(const LAS f32x4*)(KAl + j0 + 4), rk0 = *(const LAS f32x4*)(RKl + j0), rk1 = *(const LAS f32x4*)(RKl + j0 + 4);
              const f32x4 t0 = r0 * (k0 * (1.0f + (a0 - 1.0f) * ka0)) * rk0, t1 = r1 * (k1 * (1.0f + (a1 - 1.0f) * ka1)) * rk1;
              bsum += (t0[0] + t0[1]) + (t0[2] + t0[3]) + (t1[0] + t1[1]) + (t1[2] + t1[3]); }
          bsum += __shfl_xor(bsum, 32);
          if (h == 0) ((float*)(act + A_BS))[((size_t)dir * M + (size_t)b * SEQ + SCAN_TOK(c32)) * RH + hh] = bsum; }
        __builtin_amdgcn_sched_barrier(0);
        bf16x8 Pb[4], Pk[4], Qa[4], Qr[4];
#pragma unroll
        for (int q = 0; q < 4; ++q) { const int j0 = 16 * q + 8 * h;
            const f32x4 k0 = UP4(nk[q][0]), k1 = UP4(nk[q][1]), av0 = UP4(na[q][0]), av1 = UP4(na[q][1]), kr0 = UP4(nr_[q][0]), kr1 = UP4(nr_[q][1]), r0 = UP4(nq[q][0]), r1 = UP4(nq[q][1]);
            const f32x4 ka0 = *(const LAS f32x4*)(KAl + j0), ka1 = *(const LAS f32x4*)(KAl + j0 + 4);
            const f32x4 a0 = k0 * av0, a1 = k1 * av1, d0 = kr0 * (1.0f + (av0 - 1.0f) * ka0), d1 = kr1 * (1.0f + (av1 - 1.0f) * ka1);
            const f32x4 cc0 = *(const LAS f32x4*)(Cb + (c32 + 1) * CBS + j0), cc1 = *(const LAS f32x4*)(Cb + (c32 + 1) * CBS + j0 + 4), cp0 = *(const LAS f32x4*)(Cb + c32 * CBS + j0), cp1 = *(const LAS f32x4*)(Cb + c32 * CBS + j0 + 4);
            const f32x4 ct0 = *(const LAS f32x4*)(Cb + SCT * CBS + j0), ct1 = *(const LAS f32x4*)(Cb + SCT * CBS + j0 + 4);
            f32x4 i0, i1;
#pragma unroll
            for (int e = 0; e < 4; ++e) { i0[e] = __builtin_amdgcn_rcpf(cc0[e]); i1[e] = __builtin_amdgcn_rcpf(cc1[e]); }
            const f32x4 qa0 = k0 * cp0, qa1 = k1 * cp1, pb0 = a0 * i0, pb1 = a1 * i1, pk0 = d0 * i0, pk1 = d1 * i1, qr0 = r0 * cc0, qr1 = r1 * cc1;
            Qa[q] = pack8v(qa0[0], qa0[1], qa0[2], qa0[3], qa1[0], qa1[1], qa1[2], qa1[3]); Pb[q] = pack8v(pb0[0], pb0[1], pb0[2], pb0[3], pb1[0], pb1[1], pb1[2], pb1[3]);
            Pk[q] = pack8v(pk0[0], pk0[1], pk0[2], pk0[3], pk1[0], pk1[1], pk1[2], pk1[3]); Qr[q] = pack8v(qr0[0], qr0[1], qr0[2], qr0[3], qr1[0], qr1[1], qr1[2], qr1[3]);
            { const f32x4 b0 = pb0 * ct0, b1 = pb1 * ct1, e0 = pk0 * ct0, e1 = pk1 * ct1;
              *(LAS u32x2*)(TB + c32 * TS + j0 * 2) = (u32x2){cvt_pk_bf16(b0[0], b0[1]), cvt_pk_bf16(b0[2], b0[3])}; *(LAS u32x2*)(TB + c32 * TS + j0 * 2 + 8) = (u32x2){cvt_pk_bf16(b1[0], b1[1]), cvt_pk_bf16(b1[2], b1[3])};
              *(LAS u32x2*)(TK + c32 * TS + j0 * 2) = (u32x2){cvt_pk_bf16(e0[0], e0[1]), cvt_pk_bf16(e0[2], e0[3])}; *(LAS u32x2*)(TK + c32 * TS + j0 * 2 + 8) = (u32x2){cvt_pk_bf16(e1[0], e1[1]), cvt_pk_bf16(e1[2], e1[3])}; }
            const int jA = 16 * q + 4 * h, jB = jA + 8;
            const u32x2 sk0 = __builtin_amdgcn_permlane32_swap(nk[q][0].x, nk[q][1].x, false, false), sk1 = __builtin_amdgcn_permlane32_swap(nk[q][0].y, nk[q][1].y, false, false);
            const u32x2 sr0 = __builtin_amdgcn_permlane32_swap(nq[q][0].x, nq[q][1].x, false, false), sr1 = __builtin_amdgcn_permlane32_swap(nq[q][0].y, nq[q][1].y, false, false);
            const f32x4 ka = UP4(((u32x2){sk0.x, sk1.x})), kb = UP4(((u32x2){sk0.y, sk1.y})), ra = UP4(((u32x2){sr0.x, sr1.x})), rbv = UP4(((u32x2){sr0.y, sr1.y}));
            const f32x4 pa = *(const LAS f32x4*)(Cb + c32 * CBS + jA), pbv = *(const LAS f32x4*)(Cb + c32 * CBS + jB), ca = *(const LAS f32x4*)(Cb + (c32 + 1) * CBS + jA), cbv = *(const LAS f32x4*)(Cb + (c32 + 1) * CBS + jB);
            const f32x4 x0 = ka * pa, x1 = kb * pbv, y0 = ra * ca, y1 = rbv * cbv;
            ST_FRAG(FR_AT + q, pack8v(x0[0], x0[1], x0[2], x0[3], x1[0], x1[1], x1[2], x1[3]));
            ST_FRAG(FR_RT + q, pack8v(y0[0], y0[1], y0[2], y0[3], y1[0], y1[1], y1[2], y1[3])); }
        *(float*)(fr - lane * 16 + FR_CT_BYTE + lane * 4) = Cb[SCT * CBS + lane];
        asm volatile("s_waitcnt lgkmcnt(0)" ::: "memory");
#pragma unroll
        for (int q = 0; q < 4; ++q) { const int j0 = 16 * q + 8 * h; *(LAS u32x2*)(TV + c32 * TS + j0 * 2) = nv[q][0]; *(LAS u32x2*)(TV + c32 * TS + j0 * 2 + 8) = nv[q][1]; }
        asm volatile("s_waitcnt lgkmcnt(0)" ::: "memory");
#pragma unroll
        for (int mt = 0; mt < 2; ++mt)
#pragma unroll
            for (int ks = 0; ks < 2; ++ks) { const int o = trb + 16 * ks * TS + 64 * mt;
                ST_FRAG(FR_BP + 2 * mt + ks, tr_frag(TB + o, TB + o + 8 * TS));
                ST_FRAG(FR_KP + 2 * mt + ks, tr_frag(TK + o, TK + o + 8 * TS));
                ST_FRAG(FR_VF + 2 * mt + ks, tr_frag(TV + o, TV + o + 8 * TS)); }
        f32x16 Zba = {}, Zka = {}, Zbr = {}, Zkr = {};
#pragma unroll
        for (int q = 0; q < 4; ++q) { Zba = __builtin_amdgcn_mfma_f32_32x32x16_bf16(Pb[q], Qa[q], Zba, 0, 0, 0); Zka = __builtin_amdgcn_mfma_f32_32x32x16_bf16(Pk[q], Qa[q], Zka, 0, 0, 0);
            Zbr = __builtin_amdgcn_mfma_f32_32x32x16_bf16(Pb[q], Qr[q], Zbr, 0, 0, 0); Zkr = __builtin_amdgcn_mfma_f32_32x32x16_bf16(Pk[q], Qr[q], Zkr, 0, 0, 0); }
        asm volatile("s_waitcnt lgkmcnt(0)" ::: "memory"); __builtin_amdgcn_sched_barrier(0);
        f32x16 Nn, Tt;
#pragma unroll
        for (int i = 0; i < 16; ++i) { const int sr = (i & 3) + 8 * (i >> 2) + 4 * h; const bool st = sr < c32, inc = sr <= c32;
            Nn[i] = st ? -Zba[i] : 0.f; Tt[i] = Nn[i] + (sr == c32 ? 1.f : 0.f); X[sr * 36 + c32] = Nn[i];
            Zka[i] = st ? Zka[i] : 0.f; Zbr[i] = inc ? Zbr[i] : 0.f; Zkr[i] = inc ? Zkr[i] : 0.f; }
        ST_FRAG(FR_LK + 0, acc_frag(Zka, 0)); ST_FRAG(FR_LK + 1, acc_frag(Zka, 1));
        ST_FRAG(FR_MB + 0, acc_frag(Zbr, 0)); ST_FRAG(FR_MB + 1, acc_frag(Zbr, 1));
        ST_FRAG(FR_MK + 0, acc_frag(Zkr, 0)); ST_FRAG(FR_MK + 1, acc_frag(Zkr, 1));
#define ROWFRAG(ks) ({ const f32x4 lo_ = *(const LAS f32x4*)(X + c32 * 36 + 16 * (ks) + 4 * h), hi_ = *(const LAS f32x4*)(X + c32 * 36 + 16 * (ks) + 8 + 4 * h); pack8v(lo_[0], lo_[1], lo_[2], lo_[3], hi_[0], hi_[1], hi_[2], hi_[3]); })
        asm volatile("s_waitcnt lgkmcnt(0)" ::: "memory");
        bf16x8 A0 = ROWFRAG(0), A1 = ROWFRAG(1);
#pragma unroll
        for (int lvl = 0; lvl < 4; ++lvl) {
            f32x16 Pn = {};
            Pn = __builtin_amdgcn_mfma_f32_32x32x16_bf16(A0, acc_frag(Nn, 0), Pn, 0, 0, 0); Pn = __builtin_amdgcn_mfma_f32_32x32x16_bf16(A1, acc_frag(Nn, 1), Pn, 0, 0, 0);
#pragma unroll
            for (int i = 0; i < 16; ++i) X[((i & 3) + 8 * (i >> 2) + 4 * h) * 36 + c32] = Pn[i];
            asm volatile("s_waitcnt lgkmcnt(0)" ::: "memory");
            A0 = ROWFRAG(0); A1 = ROWFRAG(1);
            const bf16x8 B0 = acc_frag(Tt, 0), B1 = acc_frag(Tt, 1);
            Tt = __builtin_amdgcn_mfma_f32_32x32x16_bf16(A0, B0, Tt, 0, 0, 0); Tt = __builtin_amdgcn_mfma_f32_32x32x16_bf16(A1, B1, Tt, 0, 0, 0);
            Nn = Pn; }
#undef ROWFRAG
#pragma unroll
        for (int i = 0; i < 16; ++i) Tt[i] = -Tt[i];
        ST_FRAG(FR_TI + 0, acc_frag(Tt, 0)); ST_FRAG(FR_TI + 1, acc_frag(Tt, 1));
        asm volatile("s_waitcnt lgkmcnt(0)" ::: "memory");
#undef UP4
#undef ST_FRAG
    }
}
__device__ __forceinline__ bool scan_wait_ge(volatile LAS unsigned* p, unsigned v) {
    for (unsigned sp = 0; (int)(*p - v) < 0; ++sp) { __builtin_amdgcn_s_sleep(0); if (sp > (1u << 24)) return false; }
    return true;
}
template <int dir>
__device__ __forceinline__ void phase_scan_pair(Frame& F, int sw, int itl, unsigned epoch) {
    unsigned char* act = F.ws + WS_ACT;
    const int hh = (sw >> 1) & 15, b = sw >> 5;
    const int lane = F.lane, c32 = lane & 31, h = lane >> 5;
    unsigned char* Ys = (unsigned char*)((bf16_t*)(act + A_Y) + (size_t)dir * M * RD + (size_t)b * SEQ * RD + hh * HD + 32 * itl);
    LAS float* YB = (LAS float*)(F.lds + SCAN_NSLOT * SCAN_LSLOT) + itl * (32 * 36);
    const unsigned yo = (unsigned)((dir ? 7 - (lane >> 3) : (lane >> 3)) * RD * 2 + (lane & 7) * 8);
    const LAS float* ybr = YB + (lane >> 3) * 36 + (lane & 7) * 4;
    LAS float* ybw = YB + (4 * h) * 36 + c32;
    LAS unsigned char* lds = F.lds;
    volatile LAS unsigned* landed = (volatile LAS unsigned*)(F.lds + MISC_OFF) + 16; volatile LAS unsigned* done = landed + 2;
#define MF(a_, b_, c_) __builtin_amdgcn_mfma_f32_32x32x16_bf16(a_, b_, c_, 0, 0, 0)
    f32x16 S0 = {}, S1 = {};
    __builtin_amdgcn_s_setprio(3);
    for (int c = 0; c < NCHUNK; ++c) {
        scan_wait_ge(landed, epoch + (unsigned)c + 1u);
        asm volatile("" ::: "memory");
        f32x4 yq[4];
#pragma unroll
        for (int k = 0; k < 4; ++k) yq[k] = *(const LAS f32x4*)(ybr + 8 * k * 36);
        const LAS unsigned char* sl = lds + (c & (SCAN_NSLOT - 1)) * SCAN_LSLOT + lane * 16;
#define LF(idx) (*(const LAS bf16x8*)(sl + (idx) * 1024))
        const bf16x8 v0 = LF(FR_VF + 2 * itl), lk0 = LF(FR_LK + 0), v1 = LF(FR_VF + 2 * itl + 1), lk1 = LF(FR_LK + 1);
        const bf16x8 at0 = LF(FR_AT + 0), at1 = LF(FR_AT + 1), at2 = LF(FR_AT + 2), at3 = LF(FR_AT + 3);
        const bf16x8 rt0 = LF(FR_RT + 0), rt1 = LF(FR_RT + 1), rt2 = LF(FR_RT + 2), rt3 = LF(FR_RT + 3), ti0 = LF(FR_TI + 0), ti1 = LF(FR_TI + 1);
        __builtin_amdgcn_sched_barrier(0);
        const bf16x8 a0 = acc_frag(S0, 0), a1 = acc_frag(S0, 1), a2 = acc_frag(S1, 0), a3 = acc_frag(S1, 1);
        f32x16 X = {};
        X = MF(lk0, v0, X); X = MF(lk1, v1, X);
        X = MF(at0, a0, X); X = MF(at1, a1, X); X = MF(at2, a2, X); X = MF(at3, a3, X);
        if (c > 0) { const unsigned vo = yo + (unsigned)(dir ? SEQ - SCT - (c - 1) * SCT : (c - 1) * SCT) * (unsigned)(RD * 2);
#pragma unroll
            for (int k = 0; k < 4; ++k) __builtin_nontemporal_store(((u32x2){cvt_pk_bf16(yq[k][0], yq[k][1]), cvt_pk_bf16(yq[k][2], yq[k][3])}), (u32x2*)(Ys + (size_t)(vo + (unsigned)((dir ? 3 - k : k) * 8 * RD * 2)))); }
        f32x4 cta[4], ctb[4];
        { const LAS float* ct = (const LAS float*)(lds + (c & (SCAN_NSLOT - 1)) * SCAN_LSLOT + 28 * 1024) + 4 * h;
#pragma unroll
          for (int g = 0; g < 4; ++g) { cta[g] = *(const LAS f32x4*)(ct + 8 * g); ctb[g] = *(const LAS f32x4*)(ct + 32 + 8 * g); } }
        const bf16x8 kp0 = LF(FR_KP + 0), kp2 = LF(FR_KP + 2), kp1 = LF(FR_KP + 1), kp3 = LF(FR_KP + 3);
        __builtin_amdgcn_sched_barrier(0);
        f32x16 Yt = {};
        Yt = MF(rt0, a0, Yt); Yt = MF(rt1, a1, Yt); Yt = MF(rt2, a2, Yt); Yt = MF(rt3, a3, Yt);
        const bf16x8 mk0 = LF(FR_MK + 0), mk1 = LF(FR_MK + 1), bp0 = LF(FR_BP + 0), bp2 = LF(FR_BP + 2), bp1 = LF(FR_BP + 1), bp3 = LF(FR_BP + 3), mb0 = LF(FR_MB + 0), mb1 = LF(FR_MB + 1);
        asm volatile("" ::: "memory");
        done[itl] = epoch + (unsigned)c + 1u;
        __builtin_amdgcn_sched_barrier(0);
        const bf16x8 x0 = acc_frag(X, 0), x1 = acc_frag(X, 1);
        f32x16 U = {};
        U = MF(ti0, x0, U); U = MF(ti1, x1, U);
#pragma unroll
        for (int g = 0; g < 4; ++g)
#pragma unroll
            for (int e = 0; e < 4; ++e) { S0[4 * g + e] *= cta[g][e]; S1[4 * g + e] *= ctb[g][e]; }
        S0 = MF(kp0, v0, S0); S1 = MF(kp2, v0, S1); S0 = MF(kp1, v1, S0); S1 = MF(kp3, v1, S1);
        Yt = MF(mk0, v0, Yt); Yt = MF(mk1, v1, Yt);
        const bf16x8 u0 = acc_frag(U, 0), u1 = acc_frag(U, 1);
        S0 = MF(bp0, u0, S0); S1 = MF(bp2, u0, S1); S0 = MF(bp1, u1, S0); S1 = MF(bp3, u1, S1);
        Yt = MF(mb0, u0, Yt); Yt = MF(mb1, u1, Yt);
#pragma unroll
        for (int i = 0; i < 16; ++i) ybw[((i & 3) + 8 * (i >> 2)) * 36] = Yt[i];
#undef LF
    }
    { const unsigned vo = yo + (unsigned)(dir ? SEQ - SCT - (NCHUNK - 1) * SCT : (NCHUNK - 1) * SCT) * (unsigned)(RD * 2);
#pragma unroll
      for (int k = 0; k < 4; ++k) { const f32x4 q4 = *(const LAS f32x4*)(ybr + 8 * k * 36); __builtin_nontemporal_store(((u32x2){cvt_pk_bf16(q4[0], q4[1]), cvt_pk_bf16(q4[2], q4[3])}), (u32x2*)(Ys + (size_t)(vo + (unsigned)((dir ? 3 - k : k) * 8 * RD * 2)))); } }
    __builtin_amdgcn_s_setprio(0);
#undef MF
}
__device__ __forceinline__ void phase_scan_loader(Frame& F, int sw, unsigned epoch) {
    const int dir = sw & 1, hh = (sw >> 1) & 15, b = sw >> 5, lane = F.lane;
    const unsigned char* frs = F.ws + WS_ACT + A_FR + (size_t)(((b * RH + hh) * 2 + dir) * NCHUNK) * FR_STRIDE; const unsigned fro = (unsigned)lane * 16u;
    LAS unsigned char* lds = F.lds;
    volatile LAS unsigned* landed = (volatile LAS unsigned*)(F.lds + MISC_OFF) + 16; volatile LAS unsigned* done = landed + 2;
    for (int c = 0; c < NCHUNK; ++c) {
        if (c >= SCAN_NSLOT) { scan_wait_ge(&done[0], epoch + (unsigned)(c - SCAN_NSLOT + 1)); scan_wait_ge(&done[1], epoch + (unsigned)(c - SCAN_NSLOT + 1)); }
        asm volatile("" ::: "memory");
        const unsigned char* src = frs + (size_t)c * FR_STRIDE; LAS unsigned char* dst = lds + (c & (SCAN_NSLOT - 1)) * SCAN_LSLOT;
#pragma unroll 4
        for (int f = 0; f < 28; ++f) __builtin_amdgcn_global_load_lds((const unsigned*)(src + f * 1024 + fro), (LAS unsigned*)(dst + f * 1024), 16, 0, 2);
        __builtin_amdgcn_global_load_lds((const unsigned*)(src + 28 * 1024 + (unsigned)lane * 4u), (LAS unsigned*)(dst + 28 * 1024), 4, 0, 2);
        if (c >= 2) { asm volatile("s_waitcnt vmcnt(58)" ::: "memory"); landed[0] = epoch + (unsigned)(c - 1); }
    }
    asm volatile("s_waitcnt vmcnt(29)" ::: "memory"); landed[0] = epoch + (unsigned)(NCHUNK - 1);
    asm volatile("s_waitcnt vmcnt(0)" ::: "memory"); landed[0] = epoch + (unsigned)NCHUNK;
}

__device__ __forceinline__ void phase_post(const Args& AR, Frame& F, int l) {
    const bf16_t* V = (const bf16_t*)(F.ws + WS_ACT + A_V); const bf16_t* G = (const bf16_t*)(F.ws + WS_ACT + A_G);
    const float* BS0 = (const float*)(F.ws + WS_ACT + A_BS); const float* BS1 = BS0 + (size_t)M * RH;
    const bf16_t* Y0 = (const bf16_t*)(F.ws + WS_ACT + A_Y); const bf16_t* Y1 = Y0 + (size_t)M * RD;
    const bf16_t* OG = (const bf16_t*)(F.ws + WS_ACT + A_OG); const float* LSE = (const float*)(F.ws + WS_ACT + A_LSE);
    bf16_t* OC = (bf16_t*)(F.ws + WS_ACT + A_OCAT);
    const float* gn_w = AR.in[12] + (size_t)l * RD; const float* gn_b = AR.in[13] + (size_t)l * RD;
    { u64* ssqA = (u64*)(F.ws + WS_SSQA); u64* ssqB = (u64*)(F.ws + WS_SSQB);
      for (int i = F.bx * NTHREADS + F.tid; i < M; i += F.G * NTHREADS) { ssqA[i] = 0ull; ssqB[i] = 0ull; } }
    f32x4 gwv[2][2], gbv[2][2];
#pragma unroll
    for (int j = 0; j < 2; ++j) { const int cc = (F.lane + 64 * j) * 8; gwv[j][0] = *(const f32x4*)(gn_w + cc); gwv[j][1] = *(const f32x4*)(gn_w + cc + 4); gbv[j][0] = *(const f32x4*)(gn_b + cc); gbv[j][1] = *(const f32x4*)(gn_b + cc + 4); }
    for (int m = F.gw; m < M; m += F.NGW) {
        u32x4 ya[2], yb[2], vw[2], gw_[2], og[3]; float bsv[2], lse[3];
#pragma unroll
        for (int j = 0; j < 2; ++j) { const int cc = (F.lane + 64 * j) * 8; const size_t off = (size_t)m * RD + cc;
            ya[j] = *(const u32x4*)(Y0 + off); yb[j] = *(const u32x4*)(Y1 + off); vw[j] = *(const u32x4*)(V + off); gw_[j] = *(const u32x4*)(G + off);
            bsv[j] = BS0[(size_t)m * RH + (cc >> 6)] + BS1[(size_t)m * RH + (cc >> 6)]; }
#pragma unroll
        for (int g = 0; g < 3; ++g) { og[g] = *(const u32x4*)(OG + ((size_t)g * M + m) * AOD + F.lane * 8); lse[g] = LSE[((size_t)g * M + m) * 8 + (F.lane >> 3)]; }
        __builtin_amdgcn_sched_barrier(0);
#pragma unroll
        for (int j = 0; j < 2; ++j) { const int cc = (F.lane + 64 * j) * 8;
            float y[8], vv[8], gg[8];
            unpack8(ya[j], y); { float t[8]; unpack8(yb[j], t);
#pragma unroll
                for (int e = 0; e < 8; ++e) y[e] += t[e]; }
            unpack8(vw[j], vv); unpack8(gw_[j], gg);
            const float bs = bsv[j];
            float s = 0.f;
#pragma unroll
            for (int e = 0; e < 8; ++e) s += y[e];
            s += __shfl_xor(s, 1); s += __shfl_xor(s, 2); s += __shfl_xor(s, 4);
            const float mean = s * (1.0f / 64.0f); float q = 0.f;
#pragma unroll
            for (int e = 0; e < 8; ++e) { y[e] -= mean; q += y[e] * y[e]; }
            q += __shfl_xor(q, 1); q += __shfl_xor(q, 2); q += __shfl_xor(q, 4);
            const float rstd = __builtin_amdgcn_rsqf(q * (1.0f / 64.0f) + GN_EPS); float o[8];
#pragma unroll
            for (int e = 0; e < 8; ++e) o[e] = (y[e] * rstd * gwv[j][e >> 2][e & 3] + gbv[j][e >> 2][e & 3] + bs * vv[e]) * gg[e];
            *(u32x4*)(OC + (size_t)m * OCAT + cc) = pack8(o); }
        { const int cc = F.lane * 8;
            const float l0 = lse[0], l1 = lse[1], l2 = lse[2];
            const float mx = fmaxf(l0, fmaxf(l1, l2)); float w0 = __expf(l0 - mx), w1 = __expf(l1 - mx), w2 = __expf(l2 - mx); const float inv = 1.0f / (w0 + w1 + w2); w0 *= inv; w1 *= inv; w2 *= inv;
            float a[8], t[8], o[8]; unpack8(og[0], a);
#pragma unroll
            for (int e = 0; e < 8; ++e) o[e] = w0 * a[e];
            unpack8(og[1], t);
#pragma unroll
            for (int e = 0; e < 8; ++e) o[e] += w1 * t[e];
            unpack8(og[2], t);
#pragma unroll
            for (int e = 0; e < 8; ++e) o[e] += w2 * t[e];
            *(u32x4*)(OC + (size_t)m * OCAT + RD + cc) = pack8(o); }
    }
}

__device__ __forceinline__ void phase_final(const Args& AR, Frame& F, float* out) {
    const float* fg = AR.in[21];
    const bf16_t* HBp = (const bf16_t*)(F.ws + WS_ACT + A_HB);
    f32x4 fgv[4][2];
#pragma unroll
    for (int j = 0; j < 4; ++j) { const int c = (F.lane + 64 * j) * 8; fgv[j][0] = *(const f32x4*)(fg + c); fgv[j][1] = *(const f32x4*)(fg + c + 4); }
    for (int m = F.gw; m < M; m += F.NGW) {
        float v[4][8]; float s = 0.f;
#pragma unroll
        for (int j = 0; j < 4; ++j) { unpack8(*(const u32x4*)(HBp + (size_t)m * DM + (F.lane + 64 * j) * 8), v[j]);
#pragma unroll
            for (int e = 0; e < 8; ++e) s += v[j][e] * v[j][e]; }
        const float rs = __builtin_amdgcn_rsqf(wave_sum(s) * (1.0f / DM) + RMS_EPS);
#pragma unroll
        for (int j = 0; j < 4; ++j) { const int c = (F.lane + 64 * j) * 8; const f32x4 g0 = fgv[j][0], g1 = fgv[j][1];
            *(f32x4*)(out + (size_t)m * DM + c) = (f32x4){v[j][0] * rs * g0[0], v[j][1] * rs * g0[1], v[j][2] * rs * g0[2], v[j][3] * rs * g0[3]};
            *(f32x4*)(out + (size_t)m * DM + c + 4) = (f32x4){v[j][4] * rs * g1[0], v[j][5] * rs * g1[1], v[j][6] * rs * g1[2], v[j][7] * rs * g1[3]}; }
    }
}

constexpr int PH_PER_LAYER = 10, N_PHASES = 2 + DEPTH * PH_PER_LAYER;
__global__ void __launch_bounds__(NTHREADS, 2) fwd_kernel(Args args) {
    __shared__ __attribute__((aligned(16))) unsigned char lds_raw[LDS_BYTES];
    Frame F;
    F.lds = (LAS unsigned char*)lds_raw; F.tid = threadIdx.x; F.lane = F.tid & 63; F.wave = __builtin_amdgcn_readfirstlane(F.tid >> 6);
    F.G = gridDim.x; F.gw = blockIdx.x * NWAVES + F.wave; F.NGW = F.G * NWAVES; F.ws = args.ws;
    volatile LAS unsigned* MISC = (volatile LAS unsigned*)(F.lds + MISC_OFF);
    if (F.tid < 64) MISC[F.tid] = 0u;
    __syncthreads();
    XcdBarrier bar = xcd_barrier_post(g_bar, MISC + 8);
    const int lo = args.ph_lo, hi = args.ph_hi;
    int ph = 0;
#define PHASE_BEGIN if (ph >= lo && ph < hi) { F.ws = launder(F.ws); asm volatile("" : "+v"(F.tid)); F.lane = F.tid & 63; { int bx = blockIdx.x, wv = F.wave; asm volatile("" : "+s"(bx), "+s"(wv)); F.bx = bx; F.wave = wv; F.gw = bx * NWAVES + wv; F.lds = (LAS unsigned char*)lds_raw; } unsigned char* act = F.ws + WS_ACT; unsigned char* wl = F.ws + WS_W + (size_t)l * W_LAYER_B;
#define PHASE_END   if (ph + 1 < hi) xcd_barrier(bar); } ++ph;

    int l = 0;
    PHASE_BEGIN (void)act; (void)wl; p0_prologue(args, F);
    PHASE_END

#pragma unroll 1
    for (l = 0; l < DEPTH; ++l) {
        PHASE_BEGIN {
            pg8::Gemm g{(const bf16_t*)(act + A_HB), (const bf16_t*)(wl + WO_IN), DM, DM}; pg8::PlainSched S; S.init(M, NINP - 256, F.G, F.bx); S.nt = DM / 64;
            pg8::EpiProj E{(bf16_t*)(act + A_PROJ), (const u64*)(F.ws + WS_SSQA)};
            pg8::gemm_phase<pg8::EpiProj, pg8::PlainSched, true>(F.lds, F.tid, g, S, E);
        } PHASE_END
        PHASE_BEGIN phase_shift(args, F, l);
        PHASE_END
        PHASE_BEGIN {
            constexpr int NTAIL = M / 256;
            if (F.G > 2 * NTAIL && F.bx < NTAIL) {
                pg8::Gemm g{(const bf16_t*)(act + A_HB), (const bf16_t*)(wl + WO_IN), DM, DM}; pg8::ProjTailSched S; S.c = F.bx; { int ntv = DM / 64; asm volatile("" : "+s"(ntv)); S.nt = ntv; }
                pg8::EpiProj E{(bf16_t*)(act + A_PROJ), (const u64*)(F.ws + WS_SSQA)};
                pg8::gemm_phase<pg8::EpiProj, pg8::ProjTailSched, false>(F.lds, F.tid, g, S, E);
            } else {
                const bool split = F.G > 2 * NTAIL;
                pg8::Gemm g{(const bf16_t*)(act + A_LIN), (const bf16_t*)(wl + WO_LORA), LORA_K, LORA_K}; pg8::LoraSched S; S.init(M, LORA_N, split ? F.G - NTAIL : F.G, split ? F.bx - NTAIL : F.bx); { int ntv = 4; asm volatile("" : "+s"(ntv)); S.nt = ntv; }
                pg8::EpiLora E{act, args.in[4] + (size_t)l * 2 * RD, args.in[6] + (size_t)l * 2 * RD};
                pg8::gemm_phase<pg8::EpiLora, pg8::LoraSched, true>(F.lds, F.tid, g, S, E);
                if (split) {
                    const int wi = (F.bx - NTAIL) * NWAVES + F.wave, nw = (F.G - NTAIL) * NWAVES; LAS float* scr = (LAS float*)(F.lds + F.wave * 16384);
                    convert_weights(args, F.ws, l, 2, wi, nw, scr, F.lane, 0, 3);
                    if (l + 1 < DEPTH) convert_weights(args, F.ws, l + 1, 1, wi, nw, scr, F.lane, 0, 3); }
            }
        } PHASE_END
        PHASE_BEGIN phase_scan_prep(F, args.in[10] + (size_t)l * RD, args.in[11] + (size_t)l * RD);
        PHASE_END
        PHASE_BEGIN {
            const int nsb = BATCH * RH * 2;
            if (F.bx < nsb && F.wave < 2) { if (F.bx & 1) phase_scan_pair<1>(F, F.bx, F.wave, (unsigned)l * 256u); else phase_scan_pair<0>(F, F.bx, F.wave, (unsigned)l * 256u); }
            else if (F.bx < nsb && F.wave == 2) phase_scan_loader(F, F.bx, (unsigned)l * 256u);
            else if (F.bx >= nsb || SCAN_WG_WORKER(F.wave) >= 0) {
                const int aw0 = F.bx < nsb ? F.bx * SCAN_NSW + SCAN_WG_WORKER(F.wave) : nsb * SCAN_NSW + (F.bx - nsb) * NWAVES + F.wave, naw = nsb * SCAN_NSW + (F.G - nsb) * NWAVES;
                const int ntask = BATCH * AH * 128, n4 = ntask % naw, aw = (aw0 + naw - nsb * SCAN_NSW) % naw;
                const bool four = aw < n4; const int wcount = four ? 4 : 5, vwi = four ? (naw - n4) * 5 + aw * 4 : (aw - n4) * 5, vnw = (naw - n4) * 5 + n4 * 4;
                const bool attn_first = (F.wave & 1) != 0;
                if (attn_first) phase_attn(F, aw, naw);
                LAS float* scr = (LAS float*)(F.lds + 2 * FR_STRIDE + F.wave * 8448);
                const int cq0 = F.G > 64 ? 3 : 0;
                convert_weights(args, F.ws, l, 2, vwi, vnw, scr, F.lane, cq0, 8, wcount, aw, naw);
                if (l + 1 < DEPTH) convert_weights(args, F.ws, l + 1, 1, vwi, vnw, scr, F.lane, cq0, 8, wcount, aw, naw);
                if (!attn_first) phase_attn(F, aw, naw);
            }
        } PHASE_END

        PHASE_BEGIN phase_post(args, F, l);
        PHASE_END
        PHASE_BEGIN {
            pg8::Gemm g{(const bf16_t*)(act + A_OCAT), (const bf16_t*)(wl + WO_BR), OCAT, OCAT}; pg8::BranchSched S; S.init(M, DM, F.G, F.bx); { int ntv = AOD / 64; asm volatile("" : "+s"(ntv)); S.nt0 = ntv; }
            pg8::EpiBranch E{(bf16_t*)(act + A_Y), (const bf16_t*)(act + A_PROJ)};
            pg8::gemm_phase<pg8::EpiBranch, pg8::BranchSched, true>(F.lds, F.tid, g, S, E);
        } PHASE_END
        PHASE_BEGIN {
            pg8::Gemm g{(const bf16_t*)(act + A_Y), (const bf16_t*)(wl + WO_OUT), DM, DM}; pg8::PlainSched S; S.init(M, DM, F.G, F.bx); S.nt = DM / 64;
            if (l == 0) { pg8::EpiResid<true> E{(const void*)args.in[0], (bf16_t*)(act + A_HB), (u64*)(F.ws + WS_SSQB)}; pg8::gemm_phase<pg8::EpiResid<true>, pg8::PlainSched, true>(F.lds, F.tid, g, S, E); }
            else { pg8::EpiResid<false> E{(const void*)(act + A_HB), (bf16_t*)(act + A_HB), (u64*)(F.ws + WS_SSQB)}; pg8::gemm_phase<pg8::EpiResid<false>, pg8::PlainSched, true>(F.lds, F.tid, g, S, E); }
        } PHASE_END
        PHASE_BEGIN {
            pg8::Gemm g{(const bf16_t*)(act + A_HB), (const bf16_t*)(wl + WO_MI), DM, DM}; pg8::PlainSched S; S.init(M, DFF, F.G, F.bx); S.nt = DM / 64;
            pg8::EpiMlpIn E{(bf16_t*)(act + A_PROJ), (const u64*)(F.ws + WS_SSQB)};
            pg8::gemm_phase<pg8::EpiMlpIn, pg8::PlainSched, true>(F.lds, F.tid, g, S, E);
        } PHASE_END
        PHASE_BEGIN {
            pg8::Gemm g{(const bf16_t*)(act + A_PROJ), (const bf16_t*)(wl + WO_MO), DFF, DFF}; pg8::PlainSched S; S.init(M, DM, F.G, F.bx); S.nt = DFF / 64;
            pg8::EpiResid<false> E{(const void*)(act + A_HB), (bf16_t*)(act + A_HB), (u64*)(F.ws + WS_SSQA)};
            pg8::gemm_phase<pg8::EpiResid<false>, pg8::PlainSched, true>(F.lds, F.tid, g, S, E);
        } PHASE_END
    }
    PHASE_BEGIN (void)act; (void)wl; phase_final(args, F, args.out); PHASE_END
#undef PHASE_BEGIN
#undef PHASE_END
    __syncthreads();
    if (F.tid == 0) {
        const unsigned old = xb_add(&g_bar[XB_EXIT], 1u);
        if (old + 1u == gridDim.x) {
            __hip_atomic_store(&g_bar[XB_TMO], 0u, __ATOMIC_RELAXED, __HIP_MEMORY_SCOPE_AGENT);
            for (int j = 0; j < 16; ++j) { __hip_atomic_store(&g_bar[XB_XCNT(j)], 0u, __ATOMIC_RELAXED, __HIP_MEMORY_SCOPE_AGENT); __hip_atomic_store(&g_bar[XB_XSUB(j)], 0u, __ATOMIC_RELAXED, __HIP_MEMORY_SCOPE_AGENT); __hip_atomic_store(&g_bar[XB_XGEN(j)], 0u, __ATOMIC_RELAXED, __HIP_MEMORY_SCOPE_AGENT); }
            __hip_atomic_store(&g_bar[XB_TOP], 0u, __ATOMIC_RELAXED, __HIP_MEMORY_SCOPE_AGENT); __hip_atomic_store(&g_bar[XB_TOPGEN], 0u, __ATOMIC_RELAXED, __HIP_MEMORY_SCOPE_AGENT);
            __hip_atomic_store(&g_bar[XB_EXIT], 0u, __ATOMIC_RELAXED, __HIP_MEMORY_SCOPE_AGENT);
        }
    }
}

extern "C" void kernel_launch(void* const* d_in, const int* in_sizes, int n_in, void* d_out, int out_size, void* d_ws, size_t ws_size, hipStream_t stream) {
    static int grid = 0;
    if (grid == 0) {
        if (n_in != 22 || out_size != M * DM || ws_size < WS_END) { fprintf(stderr, "kernel_launch: unexpected shapes (n_in %d, out %d, ws %zu < %zu)\n", n_in, out_size, ws_size, (size_t)WS_END); grid = -1; return; }
        int dev = 0, cus = 0, per_cu = 0;
        if (hipGetDevice(&dev) != hipSuccess || hipDeviceGetAttribute(&cus, hipDeviceAttributeMultiprocessorCount, dev) != hipSuccess) { grid = -1; return; }
        if (hipOccupancyMaxActiveBlocksPerMultiprocessor(&per_cu, (const void*)fwd_kernel, NTHREADS, 0) != hipSuccess || per_cu < 1) fprintf(stderr, "kernel_launch: occupancy query says %d\n", per_cu);
        (void)hipGetLastError();
        grid = cus;
    }
    if (grid < 0) return;
    Args a{};
    for (int i = 0; i < 22; ++i) a.in[i] = (const float*)d_in[i];
    a.out = (float*)d_out; a.ws = (unsigned char*)d_ws;
    a.ph_lo = 0; a.ph_hi = N_PHASES;
    hipLaunchKernelGGL(fwd_kernel, dim3(grid), dim3(NTHREADS), 0, stream, a);
}
```
